# Optimizing an MI355X kernel written in HIP

```python
import math
import jax
import jax.numpy as jnp
from jax import lax
import numpy as np


D_MODEL = 1024
BATCH = 4
SEQ = 8192
DEPTH = 2

CHUNK = 64
Q_BLOCK = 128
ROPE_THETA = 10000.0
RMS_EPS = 1e-6

A_HEADS = D_MODEL // 128
A_HEAD_DIM = 64
D_A = A_HEADS * A_HEAD_DIM
IDX_HEADS = 8
IDX_DIM = 32
TOPK_MAX = 256

B_HEADS = D_MODEL // 256
B_HEAD_DIM = 64
D_B = B_HEADS * 2 * B_HEAD_DIM

D_MIX = D_A + D_B
D_FF = -(-8 * D_MODEL // (3 * 256)) * 256

IN_SPLITS = (D_A, D_A, D_A, IDX_HEADS * IDX_DIM, IDX_DIM, IDX_HEADS, D_B, D_B, D_B)
D_IN = D_A * 3 + IDX_HEADS * IDX_DIM + IDX_DIM + IDX_HEADS + D_B * 3

kernel_name = "hybrid_dsa_diffattn_swiglu_trunk"


def rms_norm(x, g):
    x32 = x.astype(jnp.float32)
    r = lax.rsqrt(jnp.mean(x32 * x32, axis=-1, keepdims=True) + RMS_EPS)
    return (x32 * r * g.astype(jnp.float32)).astype(x.dtype)


def rope_tables(seq_len, dim):
    pos = jnp.arange(seq_len, dtype=jnp.float32)
    inv = ROPE_THETA ** (-jnp.arange(0, dim, 2, dtype=jnp.float32) / dim)
    ang = pos[:, None] * inv[None, :]
    return jnp.cos(ang), jnp.sin(ang)


def apply_rope(x, cos, sin):
    half = x.shape[-1] // 2
    x32 = x.astype(jnp.float32)
    x1, x2 = x32[..., :half], x32[..., half:]
    c = cos[None, :, None, :]
    s = sin[None, :, None, :]
    return jnp.concatenate([x1 * c - x2 * s, x2 * c + x1 * s], axis=-1).astype(x.dtype)


def to_blocks(a):
    b, s = a.shape[:2]
    return jnp.swapaxes(a.reshape(b, s // Q_BLOCK, Q_BLOCK, *a.shape[2:]), 0, 1)


def from_blocks(a):
    nb, b = a.shape[:2]
    return jnp.swapaxes(a, 0, 1).reshape(b, nb * a.shape[2], *a.shape[3:])


def dsa_mixer(q, k, v, iq, ik, iw):
    s_len = q.shape[1]
    topk = min(TOPK_MAX, s_len // 4)
    key_chunk = jnp.arange(s_len) // CHUNK
    scale = A_HEAD_DIM ** -0.5
    gather = jax.vmap(lambda a, i: a[i])

    def block(args):
        bi, qb, iqb, iwb = args
        q_chunk = (bi * Q_BLOCK + jnp.arange(Q_BLOCK)) // CHUNK
        admissible = key_chunk[None, :] <= q_chunk[:, None]
        dots = jnp.einsum('bqhd,bsd->bqhs', iqb, ik,
                          preferred_element_type=jnp.float32) * (IDX_DIM ** -0.5)
        w = iwb.astype(jnp.float32) * (IDX_HEADS ** -0.5)
        score = jnp.einsum('bqhs,bqh->bqs', jax.nn.relu(dots), w)
        score = jnp.where(admissible[None], score, -jnp.inf)
        _, idx = lax.top_k(score, topk)
        k_sel = gather(k, idx)
        v_sel = gather(v, idx)
        valid = (idx // CHUNK) <= q_chunk[None, :, None]
        logits = jnp.einsum('bqhd,bqkhd->bhqk', qb, k_sel,
                            preferred_element_type=jnp.float32) * scale
        logits = jnp.where(valid[:, None], logits, -jnp.inf)
        p = jax.nn.softmax(logits, axis=-1)
        return jnp.einsum('bhqk,bqkhd->bqhd', p.astype(v.dtype), v_sel)

    nb = s_len // Q_BLOCK
    out = lax.map(block, (jnp.arange(nb), to_blocks(q), to_blocks(iq), to_blocks(iw)))
    return from_blocks(out)


def diff_mixer(q, k, v, lam, lam_init, g_subln):
    s_len = q.shape[1]
    key_chunk = jnp.arange(s_len) // CHUNK
    scale = B_HEAD_DIM ** -0.5

    def block(args):
        bi, qb = args
        q_chunk = (bi * Q_BLOCK + jnp.arange(Q_BLOCK)) // CHUNK
        admissible = key_chunk[None, :] <= q_chunk[:, None]
        logits = jnp.einsum('bqhcd,bshcd->bchqs', qb, k,
                            preferred_element_type=jnp.float32) * scale
        logits = jnp.where(admissible[None, None, None], logits, -jnp.inf)
        p = jax.nn.softmax(logits, axis=-1)
        attn = p[:, 0] - lam * p[:, 1]
        return jnp.einsum('bhqs,bshe->bqhe', attn.astype(v.dtype), v)

    nb = s_len // Q_BLOCK
    out = from_blocks(lax.map(block, (jnp.arange(nb), to_blocks(q))))
    return rms_norm(out, g_subln) * (1.0 - lam_init)


def setup_inputs(seed: int = 0) -> dict:
    key = jax.random.key(seed)
    ks = jax.random.split(key, 14)
    f32 = jnp.float32
    nrm = lambda k, shape, fan_in: jax.random.normal(k, shape, f32) * (fan_in ** -0.5)
    gain = lambda k, shape: 1.0 + 0.02 * jax.random.normal(k, shape, f32)
    return {
        "x": jax.random.normal(ks[0], (BATCH, SEQ, D_MODEL), f32),
        "w_in": nrm(ks[1], (DEPTH, D_MODEL, D_IN), D_MODEL),
        "w_out": nrm(ks[2], (DEPTH, D_MIX, D_MODEL), D_MIX),
        "g_mix": gain(ks[3], (DEPTH, D_MODEL)),
        "lam_q1": 0.1 * jax.random.normal(ks[4], (DEPTH, B_HEAD_DIM), f32),
        "lam_k1": 0.1 * jax.random.normal(ks[5], (DEPTH, B_HEAD_DIM), f32),
        "lam_q2": 0.1 * jax.random.normal(ks[6], (DEPTH, B_HEAD_DIM), f32),
        "lam_k2": 0.1 * jax.random.normal(ks[7], (DEPTH, B_HEAD_DIM), f32),
        "g_subln": gain(ks[8], (DEPTH, 2 * B_HEAD_DIM)),
        "g_ffn": gain(ks[9], (DEPTH, D_MODEL)),
        "w_gate": nrm(ks[10], (DEPTH, D_MODEL, D_FF), D_MODEL),
        "w_up": nrm(ks[11], (DEPTH, D_MODEL, D_FF), D_MODEL),
        "w_down": nrm(ks[12], (DEPTH, D_FF, D_MODEL), D_FF),
        "g_final": gain(ks[13], (D_MODEL,)),
    }


def reference(x, w_in, w_out, g_mix, lam_q1, lam_k1, lam_q2, lam_k2, g_subln,
              g_ffn, w_gate, w_up, w_down, g_final):
    b_, s_len, _ = x.shape
    cos_a, sin_a = rope_tables(s_len, A_HEAD_DIM)
    cos_i, sin_i = rope_tables(s_len, IDX_DIM)
    cos_b, sin_b = rope_tables(s_len, B_HEAD_DIM)
    split_points = [int(o) for o in np.cumsum(IN_SPLITS)[:-1]]

    for layer in range(DEPTH):
        h = rms_norm(x, g_mix[layer])
        proj = jnp.einsum('bsd,dc->bsc', h, w_in[layer])
        qa, ka, va, iq, ik, iw, qb, kb, vb = jnp.split(proj, split_points, axis=-1)

        qa = apply_rope(qa.reshape(b_, s_len, A_HEADS, A_HEAD_DIM), cos_a, sin_a)
        ka = apply_rope(ka.reshape(b_, s_len, A_HEADS, A_HEAD_DIM), cos_a, sin_a)
        va = va.reshape(b_, s_len, A_HEADS, A_HEAD_DIM)
        iq = apply_rope(iq.reshape(b_, s_len, IDX_HEADS, IDX_DIM), cos_i, sin_i)
        ik = apply_rope(ik[:, :, None, :], cos_i, sin_i)[:, :, 0, :]
        out_a = dsa_mixer(qa, ka, va, iq, ik, iw).reshape(b_, s_len, D_A)

        qb = apply_rope(qb.reshape(b_, s_len, 2 * B_HEADS, B_HEAD_DIM), cos_b, sin_b)
        kb = apply_rope(kb.reshape(b_, s_len, 2 * B_HEADS, B_HEAD_DIM), cos_b, sin_b)
        qb = qb.reshape(b_, s_len, B_HEADS, 2, B_HEAD_DIM)
        kb = kb.reshape(b_, s_len, B_HEADS, 2, B_HEAD_DIM)
        vb = vb.reshape(b_, s_len, B_HEADS, 2 * B_HEAD_DIM)
        lam_init = 0.8 - 0.6 * math.exp(-0.3 * layer)
        lam = (jnp.exp(jnp.sum(lam_q1[layer].astype(jnp.float32) * lam_k1[layer].astype(jnp.float32)))
               - jnp.exp(jnp.sum(lam_q2[layer].astype(jnp.float32) * lam_k2[layer].astype(jnp.float32)))
               + lam_init)
        out_b = diff_mixer(qb, kb, vb, lam, lam_init, g_subln[layer]).reshape(b_, s_len, D_B)

        mixed = jnp.concatenate([out_a, out_b], axis=-1)
        x = x + jnp.einsum('bsc,cd->bsd', mixed, w_out[layer])

        h2 = rms_norm(x, g_ffn[layer])
        gate = jnp.einsum('bsd,df->bsf', h2, w_gate[layer])
        up = jnp.einsum('bsd,df->bsf', h2, w_up[layer])
        x = x + jnp.einsum('bsf,fd->bsd', jax.nn.silu(gate) * up, w_down[layer])

    return rms_norm(x, g_final)
```

```cpp
#include <hip/hip_runtime.h>
#include <cstdio>
#include <cstdint>
#ifndef ATT_STAG_DIFF
#define ATT_STAG_DIFF false
#endif
#ifndef ATT_STAG_DSA
#define ATT_STAG_DSA true
#endif
#ifndef DIFF_Q1
#define DIFF_Q1 true
#endif
#ifndef DIFF_FP
#define DIFF_FP true
#endif
namespace pg8 {
#define PG8_LAS __attribute__((address_space(3)))
typedef unsigned short bf16_t;
typedef short bf16x8 __attribute__((ext_vector_type(8)));
typedef float f32x4 __attribute__((ext_vector_type(4)));
typedef unsigned u32x4 __attribute__((ext_vector_type(4)));
constexpr int BM = 256, BK = 64, HALF = 128, HTB = HALF * BK * 2  , STAGE_BYTES = 8 * HTB, NXCD = 8, WGM = 8;

__host__ __device__ __forceinline__ int lds_byte(int r, int c) { const int st = (r >> 4) * 2 + (c >> 5), rr = r & 15, cc = c & 31, ob = rr * 64 + cc * 2; return st * 1024 + (ob ^ (((ob >> 9) & 1) << 5)); }
__host__ __device__ __forceinline__ void stage_rc(int b, int& R, int& C) { const int st = b / 1024, sb = b % 1024, swz = sb ^ (((sb >> 9) & 1) << 5); R = (st >> 1) * 16 + swz / 64; C = (st & 1) * 32 + (swz % 64) / 2; }
__host__ __device__ __forceinline__ int perm32(int rho) { const int n = rho >> 4, i = rho & 15; return 8 * (i >> 2) + 4 * n + (i & 3); }

struct Unit { int pm, pn; };
struct Gemm { const bf16_t* A; const bf16_t* Bt; int M, N, K; };

struct StaticOrder {
    int nM, nN, nwg, G, c;
    __host__ __device__ void init(int M, int N, int G_, int c_) { nM = M / BM; nN = N / BM; nwg = nM * nN; G = G_; c = c_; }
    __host__ __device__ bool next(int i, Unit& u) const {
        const long L = (long)i * G + c; if (L >= nwg) return false;
        int wgid = (int)L; { const int q = nwg / NXCD, r = nwg % NXCD, xcd = wgid % NXCD, off = wgid / NXCD; wgid = (xcd < r ? xcd * (q + 1) : r * (q + 1) + (xcd - r) * q) + off; }
        const int nig = WGM * nN, gid = wgid / nig, fm = gid * WGM, gsz = (nM - fm) < WGM ? (nM - fm) : WGM;
        u.pm = fm + ((wgid % nig) % gsz); u.pn = (wgid % nig) / gsz; return true;
    }
    __device__ __forceinline__ void a_ready(const Unit&) const {}
    __device__ __forceinline__ void done(const Unit&) const {}
};

__device__ __forceinline__ unsigned cvt_pk_bf16(float lo, float hi) { unsigned r; asm volatile("v_cvt_pk_bf16_f32 %0, %1, %2" : "=v"(r) : "v"(lo), "v"(hi)); return r; }
__device__ __forceinline__ u32x4 pack8(const f32x4 a, const f32x4 b) { u32x4 w; w.x = cvt_pk_bf16(a[0], a[1]); w.y = cvt_pk_bf16(a[2], a[3]); w.z = cvt_pk_bf16(b[0], b[1]); w.w = cvt_pk_bf16(b[2], b[3]); return w; }
constexpr float RMS_EPS_F = 1e-6f;
constexpr float QK_C2 = 0.125f * 1.4426950408889634f;
constexpr size_t QKV_Q8A = 0, QKV_K8A = (size_t)16 << 20, QKV_VA = (size_t)32 << 20, QKV_QB = (size_t)64 << 20, QKV_KB = (size_t)96 << 20, QKV_VB = (size_t)128 << 20, QKV_VT8A = (size_t)160 << 20, QKV_VT8B = (size_t)176 << 20;

__device__ __forceinline__ size_t k8_tile_off(int row, int nheads, int h, int dim) { const int b = row >> 13, t = row & 8191;
    return ((((size_t)(b * nheads + h) * 128 + (t >> 6)) * 4 + (dim >> 4)) * 64 + (t & 63)) * 16 + (dim & 8); }
__device__ __forceinline__ size_t kb_tile_off(int row, int h, int dim) { const int b = row >> 13, t = row & 8191;
    return ((((size_t)(b * 4 + h) * 128 + (t >> 6)) * 8 + (dim >> 3)) * 64 + (t & 63)) * 16; }
struct EpiIn {
    static constexpr bool PERM = true, AFTER_DRAIN = false;
    const unsigned long long* ssq; unsigned char* qkv; bf16_t* IQ; bf16_t* IK; float* IW; const float* cs64; const float* cs32; unsigned char* q8b; unsigned char* k8b;
    __device__ __forceinline__ void operator()(const f32x4 (&acc)[2][2][4][2], const Unit& u, int wr, int wc, int fr_, int fq_) const {
        int fr = fr_, fq = fq_; asm volatile("" : "+v"(fr), "+v"(fq));
        const int pn = u.pn; const int row0 = u.pm * BM + wr * 64 + fr;
        const int kind = pn >> 1;
        const bool rope64 = pn < 12 && kind != 2 && kind != 5, rope32 = pn == 12 || (pn == 13 && wc == 0);
        const float* tab = rope64 ? cs64 + (4 * (wc & 1) + fq) * 8 : cs32 + fq * 8; const int tstride = rope64 ? 64 : 32;
#pragma unroll
        for (int ai = 0; ai < 2; ++ai) {
            float rs[4]; f32x4 c4[4], s4[4];
#pragma unroll
            for (int m = 0; m < 4; ++m) { const int row = row0 + ai * HALF + m * 16; rs[m] = (float)ssq[row] * (1.0f / 1048576.0f);
                if (rope64 || rope32) { const float* tp = tab + (size_t)(row & 8191) * tstride; c4[m] = *(const f32x4*)tp; s4[m] = *(const f32x4*)(tp + 4); } else { c4[m] = (f32x4){1.f, 1.f, 1.f, 1.f}; s4[m] = (f32x4){0.f, 0.f, 0.f, 0.f}; } }
#pragma unroll
            for (int m = 0; m < 4; ++m) {
                const int row = row0 + ai * HALF + m * 16;
                const float r = __builtin_amdgcn_rsqf(rs[m] * (1.0f / 1024.0f) + RMS_EPS_F);
                if (pn < 12) {
                    const size_t coff = (size_t)row * 512 + (pn & 1) * 256 + wc * 32 + 8 * fq;
                    if (kind == 2 || kind == 5) {
                        unsigned char* dst = qkv + (kind == 2 ? QKV_VA : QKV_VB) + coff;
#pragma unroll
                        for (int bj = 0; bj < 2; ++bj) { const f32x4 y1 = acc[ai][bj][m][0] * r, y2 = acc[ai][bj][m][1] * r;
                            int w0 = 0, w1 = 0; w0 = __builtin_amdgcn_cvt_pk_fp8_f32(y1[0], y1[1], w0, false); w0 = __builtin_amdgcn_cvt_pk_fp8_f32(y1[2], y1[3], w0, true);
                            w1 = __builtin_amdgcn_cvt_pk_fp8_f32(y2[0], y2[1], w1, false); w1 = __builtin_amdgcn_cvt_pk_fp8_f32(y2[2], y2[3], w1, true);
                            *(unsigned long long*)(dst + bj * HALF) = (unsigned long long)(unsigned)w0 | ((unsigned long long)(unsigned)w1 << 32); }
                    } else if (kind >= 3 && (!DIFF_Q1 || wc < 2)) {
                        const float sc = (kind == 3) ? r * QK_C2 : r;
#pragma unroll
                        for (int bj = 0; bj < 2; ++bj) { const f32x4 x1 = acc[ai][bj][m][0] * sc, x2 = acc[ai][bj][m][1] * sc;
                            bf16_t* dst = (kind == 3) ? (bf16_t*)(qkv + QKV_QB) + coff + bj * HALF
                                                      : (bf16_t*)(qkv + QKV_KB + kb_tile_off(row, 2 * (pn & 1) + bj, wc * 32 + 8 * fq));
                            *(u32x4*)dst = pack8(x1 * c4[m] - x2 * s4[m], x2 * c4[m] + x1 * s4[m]); }
                    } else {
                        const float sc = (kind == 0 || kind == 3) ? r * (QK_C2 * 8.0f) : r;
#pragma unroll
                        for (int bj = 0; bj < 2; ++bj) { const f32x4 x1 = acc[ai][bj][m][0] * sc, x2 = acc[ai][bj][m][1] * sc;
                            const f32x4 y1 = x1 * c4[m] - x2 * s4[m], y2 = x2 * c4[m] + x1 * s4[m];
                            int w0 = 0, w1 = 0; w0 = __builtin_amdgcn_cvt_pk_fp8_f32(y1[0], y1[1], w0, false); w0 = __builtin_amdgcn_cvt_pk_fp8_f32(y1[2], y1[3], w0, true);
                            w1 = __builtin_amdgcn_cvt_pk_fp8_f32(y2[0], y2[1], w1, false); w1 = __builtin_amdgcn_cvt_pk_fp8_f32(y2[2], y2[3], w1, true);
                            const int pc = (pn & 1) * 256 + bj * HALF + wc * 32 + 8 * fq;
                            unsigned char* dst = (kind == 0) ? qkv + QKV_Q8A + coff + bj * HALF : (kind == 3) ? q8b + coff + bj * HALF
                                               : (kind == 1) ? qkv + QKV_K8A + k8_tile_off(row, 8, pc >> 6, pc & 63) : k8b + k8_tile_off(row, 4, pc >> 7, (pc & 127) - 64);
                            *(unsigned long long*)dst = (unsigned long long)(unsigned)w0 | ((unsigned long long)(unsigned)w1 << 32); }
                    }
                } else if (pn == 12) {
#pragma unroll
                    for (int bj = 0; bj < 2; ++bj) { const f32x4 x1 = acc[ai][bj][m][0] * r, x2 = acc[ai][bj][m][1] * r;
                        *(u32x4*)(IQ + (size_t)row * 256 + bj * HALF + wc * 32 + 8 * fq) = pack8(x1 * c4[m] - x2 * s4[m], x2 * c4[m] + x1 * s4[m]); }
                } else {
                    if (wc == 0) {
                        const f32x4 x1 = acc[ai][0][m][0] * r, x2 = acc[ai][0][m][1] * r;
                        *(u32x4*)(IK + (size_t)row * 32 + 8 * fq) = pack8(x1 * c4[m] - x2 * s4[m], x2 * c4[m] + x1 * s4[m]);
                    } else if (wc == 1 && fq == 0) {
                        *(f32x4*)(IW + (size_t)row * 8) = acc[ai][0][m][0] * r; *(f32x4*)(IW + (size_t)row * 8 + 4) = acc[ai][0][m][1] * r;
                    }
                }
            }
            asm volatile("" ::: "memory");
        }
    }
};

struct EpiRes {
    static constexpr bool PERM = true, AFTER_DRAIN = false;
    bf16_t* xn; unsigned long long* ssq_out;
    __device__ __forceinline__ void operator()(const f32x4 (&acc)[2][2][4][2], const Unit& u, int wr, int wc, int fr_, int fq_) const {
        int fr = fr_, fq = fq_; asm volatile("" : "+v"(fr), "+v"(fq));
        const int row0 = u.pm * BM + wr * 64 + fr; const int col0 = u.pn * BM + wc * 32 + 8 * fq;
#pragma unroll
        for (int ai = 0; ai < 2; ++ai) {
            u32x4 xi[4][2];
#pragma unroll
            for (int m = 0; m < 4; ++m)
#pragma unroll
                for (int bj = 0; bj < 2; ++bj) xi[m][bj] = *(const u32x4*)(xn + (size_t)(row0 + ai * HALF + m * 16) * 1024 + col0 + bj * HALF);
#pragma unroll
            for (int m = 0; m < 4; ++m) {
                const int row = row0 + ai * HALF + m * 16; float part = 0.f;
#pragma unroll
                for (int bj = 0; bj < 2; ++bj) { const size_t off = (size_t)row * 1024 + col0 + bj * HALF; const u32x4 w = xi[m][bj];
                    const f32x4 x0 = {__uint_as_float(w.x << 16), __uint_as_float(w.x & 0xffff0000u), __uint_as_float(w.y << 16), __uint_as_float(w.y & 0xffff0000u)};
                    const f32x4 x1 = {__uint_as_float(w.z << 16), __uint_as_float(w.z & 0xffff0000u), __uint_as_float(w.w << 16), __uint_as_float(w.w & 0xffff0000u)};
                    const f32x4 o0 = x0 + acc[ai][bj][m][0], o1 = x1 + acc[ai][bj][m][1];
                    *(u32x4*)(xn + off) = pack8(o0, o1);
                    part += (o0[0] * o0[0] + o0[1] * o0[1]) + (o0[2] * o0[2] + o0[3] * o0[3]) + (o1[0] * o1[0] + o1[1] * o1[1]) + (o1[2] * o1[2] + o1[3] * o1[3]); }
                part += __shfl_xor(part, 16); part += __shfl_xor(part, 32);
                if (fq == 0) __hip_atomic_fetch_add(ssq_out + row, (unsigned long long)(part * 1048576.0f), __ATOMIC_RELAXED, __HIP_MEMORY_SCOPE_AGENT);
            }
            asm volatile("" ::: "memory");
        }
    }
};

struct EpiGU {
    static constexpr bool PERM = true, AFTER_DRAIN = false;
    const unsigned long long* ssq; bf16_t* H;
    __device__ __forceinline__ void operator()(const f32x4 (&acc)[2][2][4][2], const Unit& u, int wr, int wc, int fr_, int fq_) const {
        int fr = fr_, fq = fq_; asm volatile("" : "+v"(fr), "+v"(fq));
        const int row0 = u.pm * BM + wr * 64 + fr; const int col0 = u.pn * HALF + wc * 32 + 8 * fq;
        float rsv[2][4];
#pragma unroll
        for (int ai = 0; ai < 2; ++ai)
#pragma unroll
            for (int m = 0; m < 4; ++m) rsv[ai][m] = (float)ssq[row0 + ai * HALF + m * 16] * (1.0f / 1048576.0f);
#pragma unroll
        for (int ai = 0; ai < 2; ++ai)
#pragma unroll
            for (int m = 0; m < 4; ++m) {
                const int row = row0 + ai * HALF + m * 16;
                const float rs = __builtin_amdgcn_rsqf(rsv[ai][m] * (1.0f / 1024.0f) + RMS_EPS_F);
                f32x4 h[2];
#pragma unroll
                for (int n = 0; n < 2; ++n) { const f32x4 g = acc[ai][0][m][n] * rs, up = acc[ai][1][m][n] * rs;
#pragma unroll
                    for (int i = 0; i < 4; ++i) h[n][i] = g[i] * __builtin_amdgcn_rcpf(1.0f + __builtin_amdgcn_exp2f(g[i] * -1.4426950408889634f)) * up[i]; }
                *(u32x4*)(H + (size_t)row * 2816 + col0) = pack8(h[0], h[1]);
            }
    }
};

template <class Epi, class Sched, bool ALIGN_EPI = false, bool SP2 = false>
__device__ __forceinline__ void gemm_phase(PG8_LAS unsigned char* lds, const Gemm g, const Sched& S, const Epi& E) {
    int tid_ = threadIdx.x; asm volatile("" : "+v"(tid_));
    const int tid = tid_, wid = __builtin_amdgcn_readfirstlane(tid >> 6), lane = tid & 63, wr = wid >> 2, wc = wid & 3, fr = lane & 15, fq = lane >> 4;
    const int K = g.K, nt = K / BK;
    unsigned voffA[2], voffB[2];
#pragma unroll
    for (int i = 0; i < 2; ++i) { int R, C; stage_rc(tid * 16 + i * 8192, R, C); const int Rb = Epi::PERM ? ((R & ~31) + perm32(R & 31)) : R;
        voffA[i] = (unsigned)(R * K + C) * 2u; voffB[i] = (unsigned)(Rb * K + C) * 2u; }
    const size_t kstep = (size_t)(BK * 2);
    const size_t hstep = (size_t)HALF * K * 2;
    const size_t tstep = 2 * hstep;
    const unsigned ldsw = (unsigned)wid * 1024u;
    const int aoff = lds_byte(wr * 64 + fr, fq * 8), boff = lds_byte(wc * 32 + fr, fq * 8);
#define PG8_SA(b, h) (((b) * 2 + (h)) * HTB)
#define PG8_SB(b, h) ((4 + (b) * 2 + (h)) * HTB)
#define PG8_STAGE(bufoff, gbase, voff) do { _Pragma("unroll") for (int _i = 0; _i < 2; ++_i) \
        __builtin_amdgcn_global_load_lds((const unsigned*)((const char*)(gbase) + (voff)[_i]), (PG8_LAS unsigned*)(lds + (bufoff) + ldsw + _i * 8192), 16, 0, 0); } while (0)
#define PG8_LDA(dst, b, h) do { _Pragma("unroll") for (int m = 0; m < 4; ++m) _Pragma("unroll") for (int k = 0; k < 2; ++k) dst[m][k] = *(const PG8_LAS bf16x8*)(lds + PG8_SA(b, h) + aoff + m * 2048 + k * 1024); } while (0)
#define PG8_LDB(dst, b, h) do { _Pragma("unroll") for (int n = 0; n < 2; ++n) _Pragma("unroll") for (int k = 0; k < 2; ++k) dst[n][k] = *(const PG8_LAS bf16x8*)(lds + PG8_SB(b, h) + boff + n * 2048 + k * 1024); } while (0)
#define PG8_MMA(ai, bj, At, Bt) do { __builtin_amdgcn_s_setprio(1); _Pragma("unroll") for (int m = 0; m < 4; ++m) _Pragma("unroll") for (int n = 0; n < 2; ++n) _Pragma("unroll") for (int k = 0; k < 2; ++k) \
        acc[ai][bj][m][n] = __builtin_amdgcn_mfma_f32_16x16x32_bf16(Bt[n][k], At[m][k], acc[ai][bj][m][n], 0, 0, 0); __builtin_amdgcn_s_setprio(0); } while (0)
#define PG8_WAIT_V(n) asm volatile("s_waitcnt vmcnt(" #n ")" ::: "memory")
#define PG8_WAIT_L(n) asm volatile("s_waitcnt lgkmcnt(" #n ")" ::: "memory")
#define PG8_BAR __builtin_amdgcn_s_barrier()
#define PG8_SCHED __builtin_amdgcn_sched_barrier(0)
    Unit cur, nxt; int ui = 0;
    if (!S.next(0, cur)) return;
    f32x4 acc[2][2][4][2];
#pragma unroll
    for (int a = 0; a < 2; ++a)
#pragma unroll
        for (int b = 0; b < 2; ++b)
#pragma unroll
            for (int m = 0; m < 4; ++m)
#pragma unroll
                for (int n = 0; n < 2; ++n) acc[a][b][m][n] = (f32x4){0.f, 0.f, 0.f, 0.f};
    bf16x8 At[4][2], B0[2][2], B1[2][2];
    const char* cA = (const char*)g.A + (size_t)cur.pm * tstep; const char* cB = (const char*)g.Bt + (size_t)cur.pn * tstep;
    S.a_ready(cur);
    if constexpr (SP2) {
        PG8_STAGE(PG8_SB(0, 0), cB, voffB); PG8_STAGE(PG8_SB(0, 1), cB + hstep, voffB); PG8_STAGE(PG8_SA(0, 0), cA, voffA); PG8_STAGE(PG8_SA(0, 1), cA + hstep, voffA);
        if (wr == 1) PG8_BAR;
        PG8_WAIT_V(2); PG8_BAR;
        PG8_STAGE(PG8_SB(1, 0), cB + kstep, voffB); PG8_STAGE(PG8_SA(1, 0), cA + kstep, voffA); PG8_STAGE(PG8_SB(1, 1), cB + hstep + kstep, voffB);
        PG8_WAIT_V(6); PG8_BAR;
    } else {
        PG8_STAGE(PG8_SB(0, 0), cB, voffB); PG8_STAGE(PG8_SA(0, 0), cA, voffA); PG8_STAGE(PG8_SB(0, 1), cB + hstep, voffB); PG8_STAGE(PG8_SA(0, 1), cA + hstep, voffA);
        if (wr == 1) PG8_BAR;
        PG8_WAIT_V(4); PG8_BAR;
        PG8_STAGE(PG8_SB(1, 0), cB + kstep, voffB); PG8_STAGE(PG8_SA(1, 0), cA + kstep, voffA); PG8_STAGE(PG8_SB(1, 1), cB + hstep + kstep, voffB);
        PG8_WAIT_V(6); PG8_BAR;
    }
    for (;;) {
        const bool has_next = S.next(ui + 1, nxt);
        const char* nA = has_next ? (const char*)g.A + (size_t)nxt.pm * tstep : cA; const char* nB = has_next ? (const char*)g.Bt + (size_t)nxt.pn * tstep : cB;
        for (int t = 0; t < nt; t += 2) {
            const bool last = (t == nt - 2);
            const char* a1 = cA + (size_t)(t + 1) * kstep;
            const char* a2 = last ? nA : cA + (size_t)(t + 2) * kstep; const char* b2 = last ? nB : cB + (size_t)(t + 2) * kstep;
            const char* a3 = a2 + kstep; const char* b3 = b2 + kstep;
            if (last && has_next) S.a_ready(nxt);
            if constexpr (SP2) {
            PG8_LDB(B0, 0, 0); PG8_LDB(B1, 0, 1); PG8_SCHED; PG8_LDA(At, 0, 0); PG8_STAGE(PG8_SA(1, 1), a1 + hstep, voffA);
            PG8_WAIT_V(8); PG8_WAIT_L(0); PG8_BAR; PG8_MMA(0, 0, At, B0); PG8_MMA(0, 1, At, B1); PG8_BAR; PG8_SCHED;
            PG8_LDA(At, 0, 1); PG8_STAGE(PG8_SB(0, 0), b2, voffB); PG8_STAGE(PG8_SB(0, 1), b2 + hstep, voffB); PG8_STAGE(PG8_SA(0, 0), a2, voffA);
            PG8_WAIT_V(8); PG8_WAIT_L(0); PG8_BAR; PG8_MMA(1, 0, At, B0); PG8_MMA(1, 1, At, B1); PG8_BAR; PG8_SCHED;
            PG8_LDB(B0, 1, 0); PG8_LDB(B1, 1, 1); PG8_SCHED; PG8_LDA(At, 1, 0); PG8_STAGE(PG8_SA(0, 1), a2 + hstep, voffA);
            PG8_WAIT_V(8); PG8_WAIT_L(0); PG8_BAR; PG8_MMA(0, 0, At, B0); PG8_MMA(0, 1, At, B1); PG8_BAR; PG8_SCHED;
            PG8_LDA(At, 1, 1); PG8_STAGE(PG8_SB(1, 0), b3, voffB); PG8_STAGE(PG8_SB(1, 1), b3 + hstep, voffB); PG8_STAGE(PG8_SA(1, 0), a3, voffA);
            PG8_WAIT_V(8); PG8_WAIT_L(0); PG8_BAR; PG8_MMA(1, 0, At, B0); PG8_MMA(1, 1, At, B1); PG8_BAR; PG8_SCHED;
            } else {
            PG8_LDB(B0, 0, 0); PG8_SCHED; PG8_LDA(At, 0, 0); PG8_STAGE(PG8_SA(1, 1), a1 + hstep, voffA);
            PG8_WAIT_L(8); PG8_BAR; PG8_WAIT_L(0); PG8_MMA(0, 0, At, B0); PG8_BAR; PG8_SCHED;
            PG8_LDB(B1, 0, 1); PG8_STAGE(PG8_SB(0, 0), b2, voffB);
            PG8_BAR; PG8_WAIT_L(0); PG8_MMA(0, 1, At, B1); PG8_BAR;
            PG8_LDA(At, 0, 1); PG8_STAGE(PG8_SA(0, 0), a2, voffA);
            PG8_BAR; PG8_WAIT_L(0); PG8_MMA(1, 0, At, B0); PG8_BAR; PG8_SCHED;
            PG8_STAGE(PG8_SB(0, 1), b2 + hstep, voffB);
            PG8_WAIT_V(6); PG8_BAR; PG8_MMA(1, 1, At, B1); PG8_BAR;
            PG8_LDB(B0, 1, 0); PG8_SCHED; PG8_LDA(At, 1, 0); PG8_STAGE(PG8_SA(0, 1), a2 + hstep, voffA);
            PG8_WAIT_L(8); PG8_BAR; PG8_WAIT_L(0); PG8_MMA(0, 0, At, B0); PG8_BAR; PG8_SCHED;
            PG8_LDB(B1, 1, 1); PG8_STAGE(PG8_SB(1, 0), b3, voffB);
            PG8_BAR; PG8_WAIT_L(0); PG8_MMA(0, 1, At, B1); PG8_BAR;
            PG8_LDA(At, 1, 1); PG8_STAGE(PG8_SA(1, 0), a3, voffA);
            PG8_BAR; PG8_WAIT_L(0); PG8_MMA(1, 0, At, B0); PG8_BAR; PG8_SCHED;
            PG8_STAGE(PG8_SB(1, 1), b3 + hstep, voffB);
            PG8_WAIT_V(6); PG8_BAR; PG8_MMA(1, 1, At, B1); PG8_BAR;
            }
        }
        if constexpr (ALIGN_EPI) { if (wr == 0) PG8_BAR; }
        if constexpr (!Epi::AFTER_DRAIN) { E(acc, cur, wr, wc, fr, fq); S.done(cur); }
        if (!has_next) break;
#pragma unroll
        for (int a = 0; a < 2; ++a)
#pragma unroll
            for (int b = 0; b < 2; ++b)
#pragma unroll
                for (int m = 0; m < 4; ++m)
#pragma unroll
                    for (int n = 0; n < 2; ++n) acc[a][b][m][n] = (f32x4){0.f, 0.f, 0.f, 0.f};
        cur = nxt; cA = nA; cB = nB; ++ui;
        if constexpr (ALIGN_EPI) { if (wr == 1) PG8_BAR; }
    }
    PG8_WAIT_V(0);
    if constexpr (!ALIGN_EPI) { if (wr == 0) PG8_BAR; }
    PG8_BAR;
    if constexpr (Epi::AFTER_DRAIN) { E.fused(acc, cur, wr, wc, fr, fq, lds, wid, lane); S.done(cur); }
#undef PG8_SA
#undef PG8_SB
#undef PG8_STAGE
#undef PG8_LDA
#undef PG8_LDB
#undef PG8_MMA
#undef PG8_WAIT_V
#undef PG8_WAIT_L
#undef PG8_BAR
#undef PG8_SCHED
}
}
constexpr int NWAVES = 8;
constexpr int NB = 4, T = 8192, M = NB * T, D = 1024, DINP = 3584, DIN_SRC = 3368, DFF = 2816, NGU = 2 * DFF, NLAYER = 2;
constexpr size_t MiB = 1u << 20;
constexpr size_t WS_CTL = 0, CTL_ZERO_BYTES = 2 * MiB;
constexpr size_t WS_SSQ = 768 * 1024;
constexpr float SSQ_FIX = 1048576.0f, SSQ_UNFIX = 1.0f / 1048576.0f;
constexpr size_t WS_W = 2 * MiB, W_LAYER = 26 * MiB;
constexpr size_t WO_IN = 0, WO_OUT = 7 * MiB, WO_GU = 9 * MiB, WO_DN = 20 * MiB;
constexpr size_t WS_CS64 = 54 * MiB, WS_CS32 = 56 * MiB;
constexpr size_t WS_XN = 64 * MiB;
constexpr size_t WS_QKV = 128 * MiB;
constexpr size_t WS_H = 128 * MiB;
constexpr size_t WS_IQ = 320 * MiB, WS_IK = 336 * MiB, WS_IW = 338 * MiB;
constexpr size_t WS_MASK = 340 * MiB;
constexpr size_t WS_MIX = 372 * MiB;
constexpr size_t WS_O0 = 436 * MiB;
constexpr size_t WS_Q8B = 468 * MiB, WS_K8B = 484 * MiB;
constexpr size_t WS_END = 500 * MiB;
static_assert(WS_W + 2 * W_LAYER <= WS_CS64 && WS_H + (size_t)M * DFF * 2 <= WS_IQ && WS_O0 + (size_t)256 * 256 * 128 * 4 <= WS_END, "d_ws map");
constexpr int CW_BAR = 4096;
constexpr int RING_BYTES = 131072, LDSCTL_OFF = RING_BYTES, MISC_OFF = LDSCTL_OFF + 320, LDS_BYTES = 147456;

#define GAS __attribute__((address_space(1)))
#define LAS __attribute__((address_space(3)))
typedef unsigned short bf16;
typedef unsigned v4u __attribute__((ext_vector_type(4)));
typedef float f32x4 __attribute__((ext_vector_type(4)));
typedef float f32x16 __attribute__((ext_vector_type(16)));
typedef short bf16x8 __attribute__((ext_vector_type(8)));
typedef short s16x4 __attribute__((ext_vector_type(4)));
typedef GAS unsigned gu32;
typedef unsigned long long u64;
#define RLX_AGENT __ATOMIC_RELAXED, __HIP_MEMORY_SCOPE_AGENT
#define LDS_WAIT() asm volatile("s_waitcnt lgkmcnt(0)" ::: "memory")
#define VM_WAIT() asm volatile("s_waitcnt vmcnt(0)" ::: "memory")
__device__ __forceinline__ unsigned f2bf(float f) { unsigned u = __builtin_bit_cast(unsigned, f); return (u + 0x7fffu + ((u >> 16) & 1u)) >> 16; }
__device__ __forceinline__ unsigned pk2(float lo, float hi) { return f2bf(lo) | (f2bf(hi) << 16); }
#define XB_TMO      128
#define XB_XCNT(j)  (256  + 64 * (j))
#define XB_XSUB(j)  (1280 + 64 * (j))
#define XB_XGEN(j)  (2304 + 64 * (j))
#define XB_TOP      3328
#define XB_TOPGEN   3392
#define XCD_BAR_WORDS 3456
#define XB_SPIN_CAP (1u << 18)

__device__ __forceinline__ unsigned xb_ld(unsigned* p)              { return __hip_atomic_load(p, __ATOMIC_RELAXED, __HIP_MEMORY_SCOPE_AGENT); }
__device__ __forceinline__ unsigned xb_add(unsigned* p, unsigned v) { return __hip_atomic_fetch_add(p, v, __ATOMIC_RELAXED, __HIP_MEMORY_SCOPE_AGENT); }
__device__ __forceinline__ unsigned xb_xcc_id() { return (unsigned)__builtin_amdgcn_s_getreg((3 << 11) | 20) & 0xFu; }
#define XB_SPIN(cond, bar) do { unsigned _sp = 0; while (cond) { __builtin_amdgcn_s_sleep(1); \
    if ((++_sp & 255u) == 0u) { if (xb_ld(&(bar)[XB_TMO])) break; if (_sp > XB_SPIN_CAP) { atomicAdd(&(bar)[XB_TMO], 1u); break; } } } } while (0)

struct XcdBarrier {
    unsigned* bar; unsigned x;
    volatile LAS unsigned* st;
};

__device__ __forceinline__ XcdBarrier xcd_barrier_post(unsigned* bar, volatile LAS unsigned* st) {
    XcdBarrier b; b.bar = bar; b.x = xb_xcc_id(); b.st = st;
    if (threadIdx.x == 0) (void)xb_add(&bar[XB_XCNT(b.x)], 1u);
    return b;
}
__device__ __forceinline__ void xcd_barrier_complete(unsigned* bar, unsigned x, unsigned& nloc, unsigned& nx) {
    const unsigned G = gridDim.x * gridDim.y * gridDim.z;
    unsigned sum, cnt, mine, sp = 0u;
    for (;;) {
        sum = 0u; cnt = 0u; mine = 0u;
#pragma unroll
        for (unsigned j = 0; j < 16; ++j) { const unsigned c = xb_ld(&bar[XB_XCNT(j)]); sum += c; cnt += (c > 0u) ? 1u : 0u; mine = (j == x) ? c : mine; }
        if (sum == G) break;
        __builtin_amdgcn_s_sleep(1);
        if ((++sp & 255u) == 0u) { if (xb_ld(&bar[XB_TMO])) break; if (sp > XB_SPIN_CAP) { atomicAdd(&bar[XB_TMO], 1u); break; } }
    }
    nloc = mine > 0u ? mine : 1u; nx = cnt > 0u ? cnt : 1u;
}

__device__ __forceinline__ void xcd_barrier(const XcdBarrier& b) {
    asm volatile("s_waitcnt vmcnt(0)" ::: "memory");
    __syncthreads();
    if (threadIdx.x == 0) {
        unsigned* bar = b.bar;
        __builtin_amdgcn_s_waitcnt(0);
        unsigned nloc = b.st[0], nx = b.st[1];
        if (nloc == 0u) { xcd_barrier_complete(bar, b.x, nloc, nx); b.st[0] = nloc; b.st[1] = nx; }
        const unsigned old = xb_add(&bar[XB_XSUB(b.x)], 1u);
        const unsigned gen = old / nloc;
        if (old + 1u == (gen + 1u) * nloc) {
            __builtin_amdgcn_fence(__ATOMIC_RELEASE, "agent");
            asm volatile("s_waitcnt vmcnt(0)" ::: "memory");
            const unsigned og = xb_add(&bar[XB_TOP], 1u);
            const unsigned tg = og / nx;
            if (og + 1u == (tg + 1u) * nx) xb_add(&bar[XB_TOPGEN], 1u);
            else XB_SPIN(xb_ld(&bar[XB_TOPGEN]) == tg, bar);
            __builtin_amdgcn_fence(__ATOMIC_ACQUIRE, "agent");
            xb_add(&bar[XB_XGEN(b.x)], 1u);
            asm volatile("s_waitcnt vmcnt(0)" ::: "memory");
        } else {
            XB_SPIN(xb_ld(&bar[XB_XGEN(b.x)]) == gen, bar);
            __builtin_amdgcn_fence(__ATOMIC_ACQUIRE, "agent");
            asm volatile("s_waitcnt vmcnt(0)" ::: "memory");
        }
    }
    __syncthreads();
}
struct Frame {
    LAS unsigned char* lds;
    volatile LAS unsigned* MISC;
    gu32* ctl;
    int tid, lane, wave;
    int vcu, G;
    unsigned char* ws;
};
__device__ __forceinline__ float wave_sum(float v) {
#pragma unroll
    for (int o = 1; o < 64; o <<= 1) v += __shfl_xor(v, o);
    return v;
}
__device__ const float INV64[32] = {1.000000000e+00f, 7.498942614e-01f, 5.623413324e-01f, 4.216965139e-01f, 3.162277639e-01f, 2.371373773e-01f, 1.778279394e-01f, 1.333521307e-01f, 1.000000015e-01f, 7.498941571e-02f, 5.623413250e-02f, 4.216965288e-02f, 3.162277490e-02f, 2.371373773e-02f, 1.778279431e-02f, 1.333521493e-02f, 9.999999776e-03f, 7.498941850e-03f, 5.623413250e-03f, 4.216964822e-03f, 3.162277630e-03f, 2.371373586e-03f, 1.778279431e-03f, 1.333521446e-03f, 1.000000047e-03f, 7.498942432e-04f, 5.623413017e-04f, 4.216965172e-04f, 3.162277571e-04f, 2.371373703e-04f, 1.778279402e-04f, 1.333521504e-04f};

__device__ __forceinline__ int rope_perm64(int p) { const int g = p >> 3, i = p & 7; return (i < 4) ? 4 * g + i : 32 + 4 * g + (i - 4); }
__device__ __forceinline__ int rope_perm32(int p) { const int g = p >> 3, i = p & 7; return (i < 4) ? 4 * g + i : 16 + 4 * g + (i - 4); }
__device__ __forceinline__ int map_in(int n) {
    if (n < 3072) { const int kind = n >> 9, p = n & 511;
        const int base = (kind == 0) ? 0 : (kind == 1) ? 512 : (kind == 2) ? 1024 : (kind == 3) ? 1832 : (kind == 4) ? 2344 : 2856;
        if (kind == 2 || kind == 5) return base + p;
        return base + (p & ~63) + rope_perm64(p & 63); }
    n -= 3072; if (n < 256) return 1536 + (n & ~31) + rope_perm32(n & 31);
    n -= 256; if (n < 32) return 1792 + rope_perm32(n);
    n -= 32; if (n < 8) return 1824 + n;
    return -1;
}
template <int MODE>
__device__ __forceinline__ void transpose_item(const float* W, const float* W2, int K, int Nsrc, int Nst, const float* gain, bf16* WT, LAS float* scr, int item, int lane) {
    const int nblk = Nst / 32, kb = item / nblk, nb = item % nblk, k0 = 64 * kb, n0 = 32 * nb;
    const int r = lane >> 3, cg = lane & 7, nst = n0 + 4 * cg;
    const float* src = W; int sc = nst;
    if (MODE == 1) sc = map_in(nst);
    if (MODE == 2) { const int pn = nst >> 8, c = nst & 255; src = (c < 128) ? W : W2; sc = pn * 128 + (c & 127); }
    f32x4 tv[8];
    const int scc = sc >= 0 ? sc : 0;
#pragma unroll
    for (int i = 0; i < 8; ++i) tv[i] = __builtin_nontemporal_load((const GAS f32x4*)(src + (size_t)(k0 + r + 8 * i) * Nsrc + scc));
#pragma unroll
    for (int i = 0; i < 8; ++i) { const int kk = r + 8 * i; f32x4 v = tv[i]; if (sc < 0) v = (f32x4){0.f, 0.f, 0.f, 0.f}; if (MODE != 0) v = v * gain[k0 + kk];
        LAS float* d = scr + kk * 33 + 4 * cg; d[0] = v[0]; d[1] = v[1]; d[2] = v[2]; d[3] = v[3]; }
    LDS_WAIT(); asm volatile("" ::: "memory");
    const int c = lane & 7;
#pragma unroll
    for (int j = 0; j < 4; ++j) { const int n = (lane >> 3) + 8 * j; const LAS float* s = scr + (8 * c) * 33 + n;
        v4u o; o.x = pk2(s[0 * 33], s[1 * 33]); o.y = pk2(s[2 * 33], s[3 * 33]); o.z = pk2(s[4 * 33], s[5 * 33]); o.w = pk2(s[6 * 33], s[7 * 33]);
        *(GAS v4u*)(WT + (size_t)(n0 + n) * K + k0 + 8 * c) = o; }
    LDS_WAIT(); asm volatile("" ::: "memory");
}
struct Inputs { const float *x, *w_in, *w_out, *g_mix, *lq1, *lk1, *lq2, *lk2, *g_subln, *g_ffn, *w_gate, *w_up, *w_down, *g_final; };

__device__ __forceinline__ void p0_prologue(Frame& F, const Inputs& I) {
    LAS float* scr = (LAS float*)(F.lds + F.wave * 16384);
    const int gw = F.vcu * NWAVES + F.wave, NGW = F.G * NWAVES;
    constexpr int I_IN = (D / 64) * (DINP / 32), I_OUT = (D / 64) * (D / 32), I_GU = (D / 64) * (NGU / 32), I_DN = (DFF / 64) * (D / 32), I_LAYER = I_IN + I_OUT + I_GU + I_DN;
    for (int it = gw; it < NLAYER * I_LAYER; it += NGW) {
        const int l = it / I_LAYER; int r = it % I_LAYER;
        unsigned char* wl = F.ws + WS_W + (size_t)l * W_LAYER;
        if (r < I_IN) { transpose_item<1>(I.w_in + (size_t)l * D * DIN_SRC, nullptr, D, DIN_SRC, DINP, I.g_mix + l * D, (bf16*)(wl + WO_IN), scr, r, F.lane); continue; } r -= I_IN;
        if (r < I_OUT) { transpose_item<0>(I.w_out + (size_t)l * D * D, nullptr, D, D, D, nullptr, (bf16*)(wl + WO_OUT), scr, r, F.lane); continue; } r -= I_OUT;
        if (r < I_GU) { transpose_item<2>(I.w_gate + (size_t)l * D * DFF, I.w_up + (size_t)l * D * DFF, D, DFF, NGU, I.g_ffn + l * D, (bf16*)(wl + WO_GU), scr, r, F.lane); continue; } r -= I_GU;
        transpose_item<0>(I.w_down + (size_t)l * DFF * D, nullptr, DFF, D, D, nullptr, (bf16*)(wl + WO_DN), scr, r, F.lane);
    }
    { float* cs64 = (float*)(F.ws + WS_CS64); float* cs32 = (float*)(F.ws + WS_CS32);
      const int gt = F.vcu * (NWAVES * 64) + F.tid, NGT = F.G * NWAVES * 64;
      for (int e = gt; e < T * 48; e += NGT) {
          const int t = e / 48, jj = e % 48; const bool is64 = jj < 32; const int j = is64 ? jj : jj - 32;
          const float inv = is64 ? INV64[j] : INV64[2 * j];
          const float ang = (float)t * inv;
          double rev = (double)ang * 0.15915494309189535; rev -= __builtin_floor(rev);
          const float c = __builtin_amdgcn_cosf((float)rev), s = __builtin_amdgcn_sinf((float)rev);
          float* dst = is64 ? cs64 + (size_t)t * 64 + 8 * (j >> 2) + (j & 3) : cs32 + (size_t)t * 32 + 8 * (j >> 2) + (j & 3);
          dst[0] = c; dst[4] = s; } }
    { u64* ssq0 = (u64*)(F.ws + WS_SSQ); bf16* XN = (bf16*)(F.ws + WS_XN);
      for (int m0 = gw; m0 < M; m0 += 4 * NGW) {
          f32x4 v[4][4];
#pragma unroll
          for (int r = 0; r < 4; ++r) { const int mr = (m0 + r * NGW < M) ? m0 + r * NGW : m0; const GAS f32x4* xr = (const GAS f32x4*)(I.x + (size_t)mr * D) + F.lane;
#pragma unroll
              for (int j = 0; j < 4; ++j) v[r][j] = __builtin_nontemporal_load(xr + 64 * j); }
#pragma unroll
          for (int r = 0; r < 4; ++r) { const int m = m0 + r * NGW; if (m >= M) break; float s = 0.f;
#pragma unroll
              for (int j = 0; j < 4; ++j) s += (v[r][j].x * v[r][j].x + v[r][j].y * v[r][j].y) + (v[r][j].z * v[r][j].z + v[r][j].w * v[r][j].w);
              s = wave_sum(s);
              GAS u64* o8 = (GAS u64*)(XN + (size_t)m * D) + F.lane;
#pragma unroll
              for (int j = 0; j < 4; ++j) o8[64 * j] = (u64)pk2(v[r][j].x, v[r][j].y) | ((u64)pk2(v[r][j].z, v[r][j].w) << 32);
              if (F.lane == 0) ssq0[m] = (u64)(s * SSQ_FIX); } } }
}
__device__ __forceinline__ void final_norm(Frame& F0, float* out, const bf16* XN, const u64* ssq, const float* g) {
    Frame F = F0; { int t_ = F0.tid; asm volatile("" : "+v"(t_)); F.tid = t_; F.lane = t_ & 63; F.wave = __builtin_amdgcn_readfirstlane(t_ >> 6); }
    const int gw = F.vcu * NWAVES + F.wave, NGW = F.G * NWAVES;
    f32x4 gv[4];
#pragma unroll
    for (int j = 0; j < 4; ++j) gv[j] = ((const GAS f32x4*)g)[F.lane + 64 * j];
    for (int m0 = gw; m0 < M; m0 += 4 * NGW) {
        u64 w[4][4]; u64 sq[4];
#pragma unroll
        for (int r = 0; r < 4; ++r) { const int mr = (m0 + r * NGW < M) ? m0 + r * NGW : m0; const GAS u64* xb = (const GAS u64*)(XN + (size_t)mr * D) + F.lane; sq[r] = ssq[mr];
#pragma unroll
            for (int j = 0; j < 4; ++j) w[r][j] = __builtin_nontemporal_load(xb + 64 * j); }
#pragma unroll
        for (int r = 0; r < 4; ++r) { const int m = m0 + r * NGW; if (m >= M) break;
            GAS f32x4* xr = (GAS f32x4*)(out + (size_t)m * D) + F.lane;
            const float rs = __builtin_amdgcn_rsqf((float)sq[r] * (SSQ_UNFIX / 1024.0f) + 1e-6f);
#pragma unroll
            for (int j = 0; j < 4; ++j) { const unsigned lo = (unsigned)w[r][j], hi = (unsigned)(w[r][j] >> 32);
                const f32x4 v = {__uint_as_float(lo << 16), __uint_as_float(lo & 0xffff0000u), __uint_as_float(hi << 16), __uint_as_float(hi & 0xffff0000u)};
                __builtin_nontemporal_store(v * rs * gv[j], xr + 64 * j); } } }
}

constexpr int SEL_HIST = 0, SEL_CAND = 65536, SEL_CNT = 98304;
#define SEL_BAR() asm volatile("s_waitcnt lgkmcnt(0)\n\ts_barrier" ::: "memory")
struct SelCtx { bf16x8 afr[2][2]; float wv[2][2][8]; };
__device__ __forceinline__ float sel_relu(float x) { const int b = (int)__float_as_uint(x); return __uint_as_float((unsigned)(b > 0 ? b : 0)); }
__device__ __forceinline__ void sel_load(bf16x8 (&bfr)[2][2], const bf16* ikb, int stride, int r32, int hi) {
#pragma unroll
    for (int ct = 0; ct < 2; ++ct)
#pragma unroll
        for (int kh = 0; kh < 2; ++kh) bfr[ct][kh] = *(const bf16x8*)(ikb + (size_t)((32 * ct + r32) * stride) * 32 + 16 * kh + 8 * hi);
}
__device__ __forceinline__ void sel_scores(const SelCtx& C, const bf16x8 (&bfr)[2][2], float (&sc)[2][2][2]) {
    f32x16 acc[2][2];
#pragma unroll
    for (int at = 0; at < 2; ++at)
#pragma unroll
        for (int ct = 0; ct < 2; ++ct) { const f32x16 z = {}; acc[at][ct] = __builtin_amdgcn_mfma_f32_32x32x16_bf16(C.afr[at][0], bfr[ct][0], z, 0, 0, 0); }
#pragma unroll
    for (int at = 0; at < 2; ++at)
#pragma unroll
        for (int ct = 0; ct < 2; ++ct) acc[at][ct] = __builtin_amdgcn_mfma_f32_32x32x16_bf16(C.afr[at][1], bfr[ct][1], acc[at][ct], 0, 0, 0);
    __builtin_amdgcn_sched_barrier(0);
#pragma unroll
    for (int at = 0; at < 2; ++at)
#pragma unroll
        for (int ct = 0; ct < 2; ++ct)
#pragma unroll
            for (int r = 0; r < 16; ++r) acc[at][ct][r] = sel_relu(acc[at][ct][r]);
    __builtin_amdgcn_sched_barrier(0);
#pragma unroll
    for (int at = 0; at < 2; ++at)
#pragma unroll
        for (int ct = 0; ct < 2; ++ct) { sc[at][ct][0] = C.wv[at][0][0] * acc[at][ct][0]; sc[at][ct][1] = C.wv[at][1][0] * acc[at][ct][8]; }
#pragma unroll
    for (int r = 1; r < 8; ++r)
#pragma unroll
        for (int at = 0; at < 2; ++at)
#pragma unroll
            for (int ct = 0; ct < 2; ++ct) { sc[at][ct][0] = __builtin_fmaf(C.wv[at][0][r], acc[at][ct][r], sc[at][ct][0]); sc[at][ct][1] = __builtin_fmaf(C.wv[at][1][r], acc[at][ct][8 + r], sc[at][ct][1]); }
    __builtin_amdgcn_sched_barrier(0);
}
__device__ __forceinline__ unsigned sel_q16(float s, float c0, float inv) { return (unsigned)__builtin_amdgcn_fmed3f(__builtin_fmaf(s, inv, c0), 0.f, 65535.f); }

__device__ __forceinline__ void select_unit(Frame& F, int b, int c, const bf16* IQ, const bf16* IK, const float* IW, u64* MASK, v4u* SB) {
    const int lane = F.lane, w = F.wave, r32 = lane & 31, hi = lane >> 5, tid = F.tid;
    const size_t brow = (size_t)b * T; const int q0 = 64 * c;
    GAS u64* mrow = (GAS u64*)MASK + (size_t)b * 128 * T;
    GAS v4u* sbw = (GAS v4u*)SB + F.wave * 64 + F.lane;
    if (c < 4) {
        if (tid < 256) { const int tile = tid >> 6; mrow[(size_t)tile * T + q0 + (tid & 63)] = (tile <= c) ? ~0ull : 0ull; }
        return;
    }
    LAS unsigned* HIST = (LAS unsigned*)(F.lds + SEL_HIST);
    LAS u64* CAND = (LAS u64*)(F.lds + SEL_CAND);
    LAS int* CCNT = (LAS int*)(F.lds + SEL_CNT); LAS int* QBIN = CCNT + 64; LAS int* NEED = CCNT + 128;
    SelCtx C;
    { const int q4 = 2 * (r32 >> 4) + ((r32 >> 2) & 1), head = 4 * ((r32 >> 3) & 1) + (r32 & 3);
#pragma unroll
      for (int at = 0; at < 2; ++at)
#pragma unroll
          for (int kh = 0; kh < 2; ++kh) C.afr[at][kh] = *(const bf16x8*)(IQ + (brow + q0 + 8 * w + 4 * at + q4) * 256 + head * 32 + 16 * kh + 8 * hi);
#pragma unroll
      for (int at = 0; at < 2; ++at)
#pragma unroll
          for (int ab = 0; ab < 2; ++ab) { const float* wp = IW + (brow + q0 + 8 * w + 4 * at + 2 * ab + hi) * 8; const f32x4 a = *(const f32x4*)wp, bb = *(const f32x4*)(wp + 4);
#pragma unroll
              for (int i = 0; i < 4; ++i) { C.wv[at][ab][i] = a[i]; C.wv[at][ab][4 + i] = bb[i]; } } }
    const bf16* ik0 = IK + brow * 32;
    bf16x8 bA[2][2], bB[2][2];
    sel_load(bA, ik0, 1, r32, hi); sel_load(bB, ik0 + (size_t)64 * 32, 1, r32, hi);
    float lo[2][2], inv[2][2];
    { float sc[2][2][2]; bf16x8 bs[2][2]; sel_load(bs, ik0, c + 1, r32, hi); sel_scores(C, bs, sc);
#pragma unroll
      for (int at = 0; at < 2; ++at)
#pragma unroll
          for (int ab = 0; ab < 2; ++ab) { float s1 = sc[at][0][ab] + sc[at][1][ab], s2 = sc[at][0][ab] * sc[at][0][ab] + sc[at][1][ab] * sc[at][1][ab];
#pragma unroll
              for (int o = 1; o < 32; o <<= 1) { s1 += __shfl_xor(s1, o); s2 += __shfl_xor(s2, o); }
              const float mean = s1 * (1.f / 64.f), var = __builtin_fmaxf(s2 * (1.f / 64.f) - mean * mean, 0.f), sd = __builtin_sqrtf(var);
              inv[at][ab] = (sd > 1e-30f) ? 8192.0f / sd : 0.f; lo[at][ab] = -(mean - 2.5f * sd) * inv[at][ab]; } }
    { LAS v4u* hz = (LAS v4u*)HIST;
#pragma unroll
      for (int i = 0; i < 8; ++i) hz[tid + 512 * i] = (v4u){0u, 0u, 0u, 0u}; }
    SEL_BAR();
#define SEL_P1(BF, KB) do { float sc[2][2][2]; sel_scores(C, BF, sc); v4u rec; \
        _Pragma("unroll") for (int at = 0; at < 2; ++at) _Pragma("unroll") for (int ct = 0; ct < 2; ++ct) { unsigned q2[2]; \
            _Pragma("unroll") for (int ab = 0; ab < 2; ++ab) { q2[ab] = sel_q16(sc[at][ct][ab], lo[at][ab], inv[at][ab]); \
                __hip_atomic_fetch_add(HIST + (8 * w + 4 * at + 2 * ab + hi) * 256 + (q2[ab] >> 8), 1u, __ATOMIC_RELAXED, __HIP_MEMORY_SCOPE_WORKGROUP); } \
            rec[2 * at + ct] = q2[0] | (q2[1] << 16); } \
        __builtin_nontemporal_store(rec, sbw + (size_t)(KB) * 512); } while (0)
    for (int kb = 0; kb <= c; kb += 2) {
        SEL_P1(bA, kb); __builtin_amdgcn_sched_barrier(0); sel_load(bA, ik0 + (size_t)(kb + 2 <= c ? kb + 2 : c) * 64 * 32, 1, r32, hi);
        __builtin_amdgcn_sched_barrier(0);
        if (kb + 1 <= c) { SEL_P1(bB, kb + 1); __builtin_amdgcn_sched_barrier(0); } sel_load(bB, ik0 + (size_t)(kb + 3 <= c ? kb + 3 : c) * 64 * 32, 1, r32, hi);
    }
#undef SEL_P1
    SEL_BAR();
    for (int qi = 0; qi < 8; ++qi) {
        const int q = 8 * w + qi; const v4u hv = *(LAS v4u*)(HIST + q * 256 + 4 * lane);
        const int tot = (int)(hv[0] + hv[1] + hv[2] + hv[3]);
        int suf = tot;
#pragma unroll
        for (int o = 1; o < 64; o <<= 1) { const int tv = __shfl_down(suf, o); if (lane + o < 64) suf += tv; }
        const int above = suf - tot;
        if (suf >= 256 && above < 256) {
            int cum = above, bsel = 0, need = 1; bool found = false;
#pragma unroll
            for (int k = 3; k >= 0; --k) { if (!found) { if (cum + (int)hv[k] >= 256) { found = true; bsel = 4 * lane + k; need = 256 - cum; } else cum += (int)hv[k]; } }
            QBIN[q] = bsel; NEED[q] = need; CCNT[q] = 0;
        }
    }
    SEL_BAR();
    int qbn[2][2];
#pragma unroll
    for (int at = 0; at < 2; ++at)
#pragma unroll
        for (int ab = 0; ab < 2; ++ab) qbn[at][ab] = QBIN[8 * w + 4 * at + 2 * ab + hi];
    LAS unsigned* MST = HIST;
#define SEL_P2(RC, KB) do { unsigned q8[2][2][2]; u64 bal[2][2][2]; \
        _Pragma("unroll") for (int at = 0; at < 2; ++at) _Pragma("unroll") for (int ct = 0; ct < 2; ++ct) _Pragma("unroll") for (int ab = 0; ab < 2; ++ab) { \
            q8[at][ct][ab] = ab ? (RC[2 * at + ct] >> 16) : (RC[2 * at + ct] & 0xffffu); bal[at][ct][ab] = __ballot(q8[at][ct][ab] >= tab_[at][ab]); } \
        if (lane == 0) { _Pragma("unroll") for (int at = 0; at < 2; ++at) _Pragma("unroll") for (int ct = 0; ct < 2; ++ct) _Pragma("unroll") for (int ab = 0; ab < 2; ++ab) \
            *(LAS u64*)(MST + ((KB) * 2 + ct) * 64 + 8 * w + 4 * at + 2 * ab) = bal[at][ct][ab]; } \
        _Pragma("unroll") for (int at = 0; at < 2; ++at) _Pragma("unroll") for (int ct = 0; ct < 2; ++ct) _Pragma("unroll") for (int ab = 0; ab < 2; ++ab) { \
            const bool isc_ = (q8[at][ct][ab] >> 8) == (unsigned)qbn[at][ab]; const u64 cb_ = __ballot(isc_); \
            if (__builtin_expect(cb_ != 0ull, 0)) { const int nlo_ = __builtin_popcount((unsigned)cb_), nhi_ = __builtin_popcount((unsigned)(cb_ >> 32)); \
                const int below_ = (int)__builtin_amdgcn_mbcnt_hi((unsigned)(cb_ >> 32), __builtin_amdgcn_mbcnt_lo((unsigned)cb_, 0u)); \
                const int pos = ccv[at][ab] + (hi ? below_ - nlo_ : below_); \
                if (isc_ && pos < 64) CAND[(8 * w + 4 * at + 2 * ab + hi) * 64 + pos] = ((u64)q8[at][ct][ab] << 32) | (unsigned)((KB) * 64 + 32 * ct + r32); \
                ccv[at][ab] += hi ? nhi_ : nlo_; } } } while (0)
    int ccv[2][2] = {{0, 0}, {0, 0}};
    unsigned tab_[2][2];
#pragma unroll
    for (int at = 0; at < 2; ++at)
#pragma unroll
        for (int ab = 0; ab < 2; ++ab) tab_[at][ab] = (unsigned)(qbn[at][ab] + 1) << 8;
    { v4u ra[8], rb[8];
#pragma unroll
      for (int i = 0; i < 8; ++i) ra[i] = __builtin_nontemporal_load(sbw + (size_t)(i <= c ? i : c) * 512);
      for (int kb = 0; kb <= c; kb += 16) {
#pragma unroll
          for (int i = 0; i < 8; ++i) rb[i] = __builtin_nontemporal_load(sbw + (size_t)(kb + 8 + i <= c ? kb + 8 + i : c) * 512);
#pragma unroll
          for (int i = 0; i < 8; ++i) { if (kb + i <= c) SEL_P2(ra[i], kb + i); }
#pragma unroll
          for (int i = 0; i < 8; ++i) ra[i] = __builtin_nontemporal_load(sbw + (size_t)(kb + 16 + i <= c ? kb + 16 + i : c) * 512);
#pragma unroll
          for (int i = 0; i < 8; ++i) { if (kb + 8 + i <= c) SEL_P2(rb[i], kb + 8 + i); } } }
#undef SEL_P2
    if (r32 == 0) {
#pragma unroll
        for (int at = 0; at < 2; ++at)
#pragma unroll
            for (int ab = 0; ab < 2; ++ab) CCNT[8 * w + 4 * at + 2 * ab + hi] = ccv[at][ab]; }
    SEL_BAR();
    for (int qi = 0; qi < 8; ++qi) {
        const int q = 8 * w + qi; int n = __builtin_amdgcn_readfirstlane(CCNT[q]); n = n < 64 ? n : 64; const int need = __builtin_amdgcn_readfirstlane(NEED[q]);
        const u64 my = (lane < n) ? CAND[q * 64 + lane] : 0ull; const unsigned myv = (unsigned)(my >> 32); const unsigned myk = (unsigned)my;
        int rank = 0;
        for (int j = 0; j < n; ++j) { const unsigned vj = (unsigned)__builtin_amdgcn_readlane((int)(unsigned)(my >> 32), j); const unsigned kj = (unsigned)__builtin_amdgcn_readlane((int)myk, j); rank += (vj > myv || (vj == myv && kj < myk)) ? 1 : 0; }
        if (lane < n && rank < need) __hip_atomic_fetch_or(MST + ((myk >> 6) * 2 + ((myk >> 5) & 1)) * 64 + q, 1u << (myk & 31), __ATOMIC_RELAXED, __HIP_MEMORY_SCOPE_WORKGROUP);
    }
    SEL_BAR();
    { for (int tile = tid >> 6; tile <= c; tile += 8) mrow[(size_t)tile * T + q0 + (tid & 63)] = (u64)MST[(tile * 2) * 64 + (tid & 63)] | ((u64)MST[(tile * 2 + 1) * 64 + (tid & 63)] << 32);
      const int nz = ((c | 3) - c) * 64;
      for (int i = tid; i < nz; i += 512) mrow[(size_t)(c + 1 + (i >> 6)) * T + q0 + (i & 63)] = 0ull; }
    SEL_BAR();
}
namespace att { __device__ __forceinline__ int crow(int r, int hi); }
template <int NJ>
__device__ __forceinline__ void vt8_jobs(Frame& F, int job0) {
    const int slab = F.wave & 1, cc = F.wave >> 1, h = cc >> 1, kb = 32 * (cc & 1), col = slab * 256 + 4 * F.lane;
    unsigned d[NJ][16];
#pragma unroll
    for (int jj = 0; jj < NJ; ++jj) { const int job = job0 + jj, mixer = job >> 9, b = (job >> 7) & 3, tile = job & 127;
        const unsigned char* V = F.ws + WS_QKV + (mixer ? pg8::QKV_VB : pg8::QKV_VA) + ((size_t)b * T + tile * 64) * 512 + col;
#pragma unroll
        for (int j = 0; j < 16; ++j) d[jj][j] = __builtin_nontemporal_load((const unsigned*)(V + (size_t)(kb + att::crow(j, h)) * 512)); }
#pragma unroll
    for (int jj = 0; jj < NJ; ++jj) { const int job = job0 + jj, mixer = job >> 9, b = (job >> 7) & 3, tile = job & 127;
        unsigned char* VT = F.ws + WS_QKV + (mixer ? pg8::QKV_VT8B + ((((size_t)(b * 4 + (col >> 7)) * 128 + tile) * 4 + cc) * 128 + (col & 127)) * 16
                                                   : pg8::QKV_VT8A + ((((size_t)(b * 8 + (col >> 6)) * 128 + tile) * 4 + cc) * 64 + (col & 63)) * 16);
        v4u o[4];
#pragma unroll
        for (int q = 0; q < 4; ++q) { const unsigned t0 = __builtin_amdgcn_perm(d[jj][4 * q + 1], d[jj][4 * q], 0x05010400u), t1 = __builtin_amdgcn_perm(d[jj][4 * q + 1], d[jj][4 * q], 0x07030602u);
            const unsigned u0 = __builtin_amdgcn_perm(d[jj][4 * q + 3], d[jj][4 * q + 2], 0x05010400u), u1 = __builtin_amdgcn_perm(d[jj][4 * q + 3], d[jj][4 * q + 2], 0x07030602u);
            o[0][q] = __builtin_amdgcn_perm(u0, t0, 0x05040100u); o[1][q] = __builtin_amdgcn_perm(u0, t0, 0x07060302u);
            o[2][q] = __builtin_amdgcn_perm(u1, t1, 0x05040100u); o[3][q] = __builtin_amdgcn_perm(u1, t1, 0x07060302u); }
#pragma unroll
        for (int c = 0; c < 4; ++c) *(v4u*)(VT + c * 16) = o[c]; }
}
__device__ __forceinline__ void select_phase(Frame& F0, float* out) {
    Frame F = F0; { int t_ = F0.tid; asm volatile("" : "+v"(t_)); F.tid = t_; F.lane = t_ & 63; F.wave = __builtin_amdgcn_readfirstlane(t_ >> 6); }
    const bf16* IQ = (const bf16*)(F.ws + WS_IQ); const bf16* IK = (const bf16*)(F.ws + WS_IK); const float* IW = (const float*)(F.ws + WS_IW); u64* MASK = (u64*)(F.ws + WS_MASK);
    for (int v = F.vcu; v < 256; v += F.G) {
        const int b = v >> 6, s = v & 63;
        const size_t pre = (size_t)(128 * s - (s * (s - 1)) / 2);
        unsigned char* sbp = (b == 0) ? (unsigned char*)out + pre * 8192 : (b == 1) ? (unsigned char*)out + (6176 + pre) * 8192 : (b == 2) ? F.ws + WS_MIX + pre * 8192
                           : (s < 32) ? (unsigned char*)out + (2 * 6176 + pre) * 8192 : F.ws + WS_O0 + (pre - 3600) * 8192;
        v4u* SB = (v4u*)sbp;
#pragma unroll 1
        for (int i = 0; i < 2; ++i) { select_unit(F, b, i == 0 ? s : 127 - s, IQ, IK, IW, MASK, SB);
            if (i == 0) {
#pragma unroll 1
                for (int j = 0; j < 4; j += 2) vt8_jobs<2>(F, 4 * v + j); } }
    }
}

namespace att {
constexpr int LDS_K = 0, LDS_V = 32768, LDS_Q = 65536, LDS_MK = 98304, LDS_WS = 106496, LDS_ONES = 108544, LDS_OST = 0;
__device__ __forceinline__ int crow(int r, int hi) { return (r & 3) + 8 * (r >> 2) + 4 * hi; }
template <int OFF> __device__ __forceinline__ void glds16o(const void* gsrc, unsigned lds_base) { unsigned keep;
    asm volatile("s_mov_b32 %0, m0\n\ts_add_u32 m0, %2, %3\n\ts_nop 0\n\tglobal_load_lds_dwordx4 %1, off\n\ts_mov_b32 m0, %0" : "=&s"(keep) : "v"(gsrc), "s"(lds_base), "n"(OFF) : "memory", "scc"); }
template <int OFF> __device__ __forceinline__ void glds4o(const void* gsrc, unsigned lds_base) { unsigned keep;
    asm volatile("s_mov_b32 %0, m0\n\ts_add_u32 m0, %2, %3\n\ts_nop 0\n\tglobal_load_lds_dword %1, off\n\ts_mov_b32 m0, %0" : "=&s"(keep) : "v"(gsrc), "s"(lds_base), "n"(OFF) : "memory", "scc"); }
template <int OFF> __device__ __forceinline__ void glds16s(unsigned voff, const void* sbase, unsigned lds_base) { unsigned keep;
    asm volatile("s_mov_b32 %0, m0\n\ts_add_u32 m0, %3, %4\n\ts_nop 0\n\tglobal_load_lds_dwordx4 %1, %2\n\ts_mov_b32 m0, %0" : "=&s"(keep) : "v"(voff), "s"(sbase), "s"(lds_base), "n"(OFF) : "memory", "scc"); }
template <int OFF> __device__ __forceinline__ void glds4s(unsigned voff, const void* sbase, unsigned lds_base) { unsigned keep;
    asm volatile("s_mov_b32 %0, m0\n\ts_add_u32 m0, %3, %4\n\ts_nop 0\n\tglobal_load_lds_dword %1, %2\n\ts_mov_b32 m0, %0" : "=&s"(keep) : "v"(voff), "s"(sbase), "s"(lds_base), "n"(OFF) : "memory", "scc"); }
__device__ __forceinline__ float max3f(float a, float b, float c) { return __builtin_fmaxf(__builtin_fmaxf(a, b), c); }
typedef float f32x2_t __attribute__((ext_vector_type(2))); typedef __bf16 bf16x2_t __attribute__((ext_vector_type(2)));
__device__ __forceinline__ unsigned cvtpk_s(float lo, float hi) { f32x2_t v = {lo, hi}; bf16x2_t b = __builtin_convertvector(v, bf16x2_t); return __builtin_bit_cast(unsigned, b); }
#define ATT_WAIT_BAR() asm volatile("s_waitcnt vmcnt(0) lgkmcnt(0)\n\ts_barrier" ::: "memory")
__device__ __forceinline__ float rowmax(const f32x16& p0, const f32x16& p1) {
    float a = max3f(p0[0], p0[1], p1[0]), b = max3f(p0[2], p0[3], p1[1]); a = max3f(a, p1[2], p1[3]);
#pragma unroll
    for (int r = 4; r < 16; r += 4) { a = max3f(a, p0[r], p0[r + 1]); b = max3f(b, p0[r + 2], p0[r + 3]); a = max3f(a, p1[r], p1[r + 1]); b = max3f(b, p1[r + 2], p1[r + 3]); }
    const float m = __builtin_fmaxf(a, b);
    auto rr = __builtin_amdgcn_permlane32_swap(__float_as_uint(m), __float_as_uint(m), false, false);
    float m2; asm("v_max_f32 %0, %1, %2" : "=v"(m2) : "v"(rr[0]), "v"(rr[1]));
    return m2;
}
typedef int v8i __attribute__((ext_vector_type(8)));
constexpr float ATT_THR = 8.0f, ATT_C0 = 4.0f;
constexpr int SC_ONE = 0x7F7F7F7F, SC_8TH = 0x7C7C7C7C;
__device__ __forceinline__ void qkt8(f32x16& p0, f32x16& p1, const LAS char* Kslot, const v8i& q8, const f32x16& c, int r32, int hi) {
    const LAS char* kb = Kslot + hi * 2048 + r32 * 16;
    const v4u a00 = *(const LAS v4u*)(kb), a01 = *(const LAS v4u*)(kb + 1024), a10 = *(const LAS v4u*)(kb + 512), a11 = *(const LAS v4u*)(kb + 1024 + 512);
    __builtin_amdgcn_sched_barrier(0);
    const v8i A0 = {(int)a00[0], (int)a00[1], (int)a00[2], (int)a00[3], (int)a01[0], (int)a01[1], (int)a01[2], (int)a01[3]};
    const v8i A1 = {(int)a10[0], (int)a10[1], (int)a10[2], (int)a10[3], (int)a11[0], (int)a11[1], (int)a11[2], (int)a11[3]};
    p0 = __builtin_amdgcn_mfma_scale_f32_32x32x64_f8f6f4(A0, q8, c, 0, 0, 0, SC_ONE, 0, SC_8TH);
    p1 = __builtin_amdgcn_mfma_scale_f32_32x32x64_f8f6f4(A1, q8, c, 0, 0, 0, SC_ONE, 0, SC_8TH);
}
template <int ND>
__device__ __forceinline__ void pv8(f32x16* o, f32x16& osum, const LAS char* Vslot, const LAS char* onesp, const v8i& pa, int r32, int hi) {
    const v4u on0 = *(const LAS v4u*)onesp, on1 = *(const LAS v4u*)(onesp + 16);
    v4u b0[ND], b1[ND];
#pragma unroll
    for (int d = 0; d < ND; ++d) { const LAS char* vb = Vslot + (2 * hi) * (ND * 32 * 16) + (32 * d + r32) * 16; b0[d] = *(const LAS v4u*)vb; b1[d] = *(const LAS v4u*)(vb + ND * 32 * 16); }
    __builtin_amdgcn_sched_barrier(0);
#pragma unroll
    for (int d = 0; d < ND; ++d) { const v8i B = {(int)b0[d][0], (int)b0[d][1], (int)b0[d][2], (int)b0[d][3], (int)b1[d][0], (int)b1[d][1], (int)b1[d][2], (int)b1[d][3]};
        o[d] = __builtin_amdgcn_mfma_scale_f32_32x32x64_f8f6f4(pa, B, o[d], 0, 0, 0, SC_ONE, 0, SC_ONE); }
    const v8i ones = {(int)on0[0], (int)on0[1], (int)on0[2], (int)on0[3], (int)on1[0], (int)on1[1], (int)on1[2], (int)on1[3]};
    osum = __builtin_amdgcn_mfma_scale_f32_32x32x64_f8f6f4(pa, ones, osum, 0, 0, 0, SC_ONE, 0, SC_ONE);
}
template <bool QLDS>
__device__ __forceinline__ void qkt_c(f32x16& p0, f32x16& p1, const LAS char* Kslot, const bf16x8* qr, const LAS char* qst, const f32x16& c, int r32, int hi) {
    const LAS char* kb = Kslot + hi * 1024 + r32 * 16;
    bf16x8 kf[8], q[4];
#pragma unroll
    for (int d0 = 0; d0 < 4; ++d0) { kf[2 * d0] = *(const LAS bf16x8*)(kb + d0 * 2048); kf[2 * d0 + 1] = *(const LAS bf16x8*)(kb + d0 * 2048 + 512);
        q[d0] = QLDS ? *(const LAS bf16x8*)(qst + d0 * 1024) : qr[d0]; }
    __builtin_amdgcn_sched_barrier(0);
#pragma unroll
    for (int d0 = 0; d0 < 4; ++d0) {
        if (d0 == 0) { p0 = __builtin_amdgcn_mfma_f32_32x32x16_bf16(kf[0], q[0], c, 0, 0, 0); p1 = __builtin_amdgcn_mfma_f32_32x32x16_bf16(kf[1], q[0], c, 0, 0, 0); }
        else { p0 = __builtin_amdgcn_mfma_f32_32x32x16_bf16(kf[2 * d0], q[d0], p0, 0, 0, 0); p1 = __builtin_amdgcn_mfma_f32_32x32x16_bf16(kf[2 * d0 + 1], q[d0], p1, 0, 0, 0); } }
}
typedef short v4i16_t __attribute__((ext_vector_type(4)));
__device__ __forceinline__ s16x4 vtr(const LAS char* p) { return __builtin_bit_cast(s16x4, __builtin_amdgcn_ds_read_tr16_b64_v4i16((LAS v4i16_t*)p)); }
template <int ND>
__device__ __forceinline__ void pv2(f32x16* o, f32x16& osum, const LAS char* vp, const v4u (&pw)[4]) {
    const bf16x8 ones = {(short)0x3F80, (short)0x3F80, (short)0x3F80, (short)0x3F80, (short)0x3F80, (short)0x3F80, (short)0x3F80, (short)0x3F80};
    s16x4 lo[2][4], hi[2][4];
#define ATT_VRD(d, b) do { const LAS char* vd_ = vp + ((d) >> 1) * 8192 + ((d) & 1) * 4096; \
        _Pragma("unroll") for (int ks = 0; ks < 4; ++ks) { lo[b][ks] = vtr(vd_ + ks * 1024); hi[b][ks] = vtr(vd_ + ks * 1024 + 512); } } while (0)
    ATT_VRD(0, 0);
    __builtin_amdgcn_sched_barrier(0);
#pragma unroll
    for (int d = 0; d < ND; ++d) {
        if (d + 1 < ND) ATT_VRD(d + 1, (d + 1) & 1);
        __builtin_amdgcn_sched_barrier(0);
#pragma unroll
        for (int ks = 0; ks < 4; ++ks) { const s16x4 l_ = lo[d & 1][ks], h_ = hi[d & 1][ks];
            const bf16x8 vf = {l_[0], l_[1], l_[2], l_[3], h_[0], h_[1], h_[2], h_[3]};
            o[d] = __builtin_amdgcn_mfma_f32_32x32x16_bf16(__builtin_bit_cast(bf16x8, pw[ks]), vf, o[d], 0, 0, 0); }
        __builtin_amdgcn_sched_barrier(0);
    }
#undef ATT_VRD
#pragma unroll
    for (int ks = 0; ks < 4; ++ks) osum = __builtin_amdgcn_mfma_f32_32x32x16_bf16(__builtin_bit_cast(bf16x8, pw[ks]), ones, osum, 0, 0, 0);
}
template <int ND>
__device__ __forceinline__ void soft_ref(f32x16& S0, f32x16& S1, f32x16& negm, float& mref, f32x16* o, f32x16& osum, LAS float* wsf, int r32, int hi, bool first) {
    const float rm = rowmax(S0, S1);
    if (__builtin_expect(first || __any(rm > ATT_THR), 0)) {
        const float dl = first ? rm - ATT_C0 : __builtin_fmaxf(rm - ATT_C0, 0.f); mref += dl;
#pragma unroll
        for (int r = 0; r < 16; ++r) { S0[r] -= dl; S1[r] -= dl; negm[r] = -mref; }
        const float f = __builtin_amdgcn_exp2f(-dl);
        if (hi == 0) wsf[r32] = f;
        LDS_WAIT();
#pragma unroll
        for (int r = 0; r < 16; ++r) { const float fr = wsf[crow(r, hi)]; osum[r] *= fr;
#pragma unroll
            for (int d = 0; d < ND; ++d) o[d][r] *= fr; }
    }
}
template <bool MASKED, bool FP>
__device__ __forceinline__ void soft_exp(f32x16& S0, f32x16& S1, u64 mw, v8i& pa, v4u (&pw)[4], int hi) {
#pragma unroll
    for (int r = 0; r < 16; ++r) { S0[r] = __builtin_amdgcn_exp2f(S0[r]); S1[r] = __builtin_amdgcn_exp2f(S1[r]); }
    if (MASKED && !FP) { const int x0 = (int)((unsigned)mw >> (4 * hi)), x1 = (int)((unsigned)(mw >> 32) >> (4 * hi));
#pragma unroll
        for (int r = 0; r < 16; ++r) { int m0_, m1_;
            asm("v_bfe_i32 %0, %1, %2, 1" : "=v"(m0_) : "v"(x0), "n"((r & 3) + 8 * (r >> 2)));
            asm("v_bfe_i32 %0, %1, %2, 1" : "=v"(m1_) : "v"(x1), "n"((r & 3) + 8 * (r >> 2)));
            S0[r] = __uint_as_float(__float_as_uint(S0[r]) & (unsigned)m0_); S1[r] = __uint_as_float(__float_as_uint(S1[r]) & (unsigned)m1_); } }
    if (FP) {
        unsigned cm1 = 0x01010101u, cm2 = 0x0C0C0C0Cu; if (MASKED) { asm volatile("" : "+v"(cm1)); asm volatile("" : "+s"(cm2)); }
#pragma unroll
        for (int d = 0; d < 4; ++d) { int w0 = (int)__float_as_uint(S0[4 * d]), w1 = (int)__float_as_uint(S1[4 * d]);
            w0 = __builtin_amdgcn_cvt_pk_fp8_f32(S0[4 * d], S0[4 * d + 1], w0, false); w0 = __builtin_amdgcn_cvt_pk_fp8_f32(S0[4 * d + 2], S0[4 * d + 3], w0, true);
            w1 = __builtin_amdgcn_cvt_pk_fp8_f32(S1[4 * d], S1[4 * d + 1], w1, false); w1 = __builtin_amdgcn_cvt_pk_fp8_f32(S1[4 * d + 2], S1[4 * d + 3], w1, true);
            if (MASKED) {
                const unsigned n0 = ((unsigned)mw >> (8 * d + 4 * hi)) & 15u, n1 = ((unsigned)(mw >> 32) >> (8 * d + 4 * hi)) & 15u;
                const unsigned s0 = (__umul24(n0, 0x204081u) & cm1) | cm2, s1 = (__umul24(n1, 0x204081u) & cm1) | cm2;
                w0 &= (int)__builtin_amdgcn_perm(0u, 0u, s0); w1 &= (int)__builtin_amdgcn_perm(0u, 0u, s1); }
            pa[d] = w0; pa[4 + d] = w1; }
    } else {
        pw[0] = (v4u){cvtpk_s(S0[0], S0[1]), cvtpk_s(S0[2], S0[3]), cvtpk_s(S0[4], S0[5]), cvtpk_s(S0[6], S0[7])};
        pw[1] = (v4u){cvtpk_s(S0[8], S0[9]), cvtpk_s(S0[10], S0[11]), cvtpk_s(S0[12], S0[13]), cvtpk_s(S0[14], S0[15])};
        pw[2] = (v4u){cvtpk_s(S1[0], S1[1]), cvtpk_s(S1[2], S1[3]), cvtpk_s(S1[4], S1[5]), cvtpk_s(S1[6], S1[7])};
        pw[3] = (v4u){cvtpk_s(S1[8], S1[9]), cvtpk_s(S1[10], S1[11]), cvtpk_s(S1[12], S1[13]), cvtpk_s(S1[14], S1[15])};
    }
}
template <int DV, bool MASKED, int OUT, bool FQ, bool FP, bool STAG = false>
__device__ __forceinline__ void attn_unit(LAS char* shm, int wid, int lane, const void* Qp_, const void* Kp_, const void* Vp_, int qb, const GAS u64* maskp, bf16* Od, float* O0s, float lam, float osc, const float* gsub) {
    constexpr int ND = DV / 32, NSUB = DV / 64, KSL = FQ ? 4096 : 8192, VSL = FP ? DV * 64 : NSUB * 8192;
    constexpr int IPS = (FQ && FP) ? 2 : ((FQ ? 1 : 1) + (FP ? 1 : NSUB) + (MASKED ? 1 : 0));
    static_assert(!(FQ && !FP) && !(FP && DV == 64 && !FQ), "supported: all bf16; all fp8; bf16 QK^T with fp8 P.V at DV 128");
    const int r32 = lane & 31, hi = lane >> 5;
    const unsigned lds0 = (unsigned)(size_t)shm;
    LAS float* wsf = (LAS float*)(shm + LDS_WS) + wid * 64;
    const LAS char* mring = shm + LDS_MK + wid * 1024;
    const int NT = 4 * qb + 4, cq = 4 * qb + (wid >> 1);
    const unsigned wbase = (unsigned)__builtin_amdgcn_readfirstlane(lds0 + wid * 1024);
    constexpr int KTB = FQ ? 4096 : 8192, VTB = DV * 64;
    const unsigned kvo = (unsigned)lane * 16u;
    const unsigned char* ksb = (const unsigned char*)Kp_ + (FQ ? (wid & 3) : wid) * 1024;
    const unsigned kbase = FQ ? (unsigned)__builtin_amdgcn_readfirstlane(lds0 + (wid & 3) * 1024) : wbase;
    const unsigned vvo = FP ? (unsigned)lane * 16u : (unsigned)((lane >> 2) * 1024 + (lane & 3) * 16);
    const unsigned char* vsb = FP ? (const unsigned char*)Vp_ + (DV == 64 ? (wid & 3) * 1024 : (wid & 3) * 2048 + (wid >> 2) * 1024)
                                  : (const unsigned char*)Vp_ + (size_t)(16 * (wid & 3)) * 1024 + (wid >> 2) * 64;
    const unsigned vbase = FP ? (unsigned)__builtin_amdgcn_readfirstlane(lds0 + (DV == 64 ? (wid & 3) * 1024 : (wid & 3) * 2048 + (wid >> 2) * 1024)) : wbase;
    const LAS char* vp0 = shm + LDS_V + ((lane >> 4) & 1) * 32 + (lane & 3) * 8 + (4 * hi + ((lane & 15) >> 2)) * 64;
    const unsigned mvo = (unsigned)lane * 4u;
    const unsigned char* msb = MASKED ? (const unsigned char*)(maskp + qb * 256 + wid * 32) : nullptr;
#define ATT_DMA(t, slot) do { \
        if (FQ) { if (wid < 4) glds16s<LDS_K + (slot) * KSL>(kvo, ksb + (size_t)(t) * KTB, kbase); } \
        else glds16s<LDS_K + (slot) * KSL>(kvo, ksb + (size_t)(t) * KTB, kbase); \
        if (FP) { if (DV == 128 || wid >= 4) glds16s<LDS_V + (slot) * VSL>(vvo, vsb + (size_t)(t) * VTB, vbase); \
                  if (FQ && DV == 128 && wid >= 4) glds16s<LDS_V + (slot) * VSL>(vvo, vsb + (size_t)(t) * VTB, vbase); }     \
        else { glds16s<LDS_V + (slot) * VSL>(vvo, vsb + (size_t)(t) * 64 * 1024, vbase); if (NSUB == 2) glds16s<LDS_V + (slot) * VSL + 8192>(vvo, vsb + (size_t)(t) * 64 * 1024 + 128, vbase); } \
        if (MASKED) glds4s<LDS_MK + (slot) * 256>(mvo, msb + (size_t)(t) * (8 * T), wbase); } while (0)
#define ATT_WAITN(n) do { if ((n) == 2) asm volatile("s_waitcnt vmcnt(2) lgkmcnt(0)\n\ts_barrier" ::: "memory"); else if ((n) == 3) asm volatile("s_waitcnt vmcnt(3) lgkmcnt(0)\n\ts_barrier" ::: "memory"); \
        else asm volatile("s_waitcnt vmcnt(0) lgkmcnt(0)\n\ts_barrier" ::: "memory"); } while (0)
    static_assert(IPS == 2 || IPS == 3, "counted waits exist for 2 and 3 DMA instructions per tile");
    if (FP && wid == 0 && lane < 8) ((LAS unsigned*)(shm + LDS_ONES))[lane] = 0x38383838u;
    unsigned onesa = lds0 + LDS_ONES; asm volatile("" : "+v"(onesa));
    bf16x8 qr[4] = {}; v8i q8 = {};
    if (FQ) { const unsigned char* Qw = (const unsigned char*)Qp_ + (size_t)(qb * 256 + wid * 32) * 512; v4u qa, qb_;
        asm volatile("global_load_dwordx4 %0, %1, off" : "=v"(qa) : "v"(Qw + (size_t)r32 * 512 + hi * 32) : "memory"); asm volatile("global_load_dwordx4 %0, %1, off" : "=v"(qb_) : "v"(Qw + (size_t)r32 * 512 + hi * 32 + 16) : "memory");
        ATT_DMA(0, 0); ATT_DMA(1, 1);
        if (IPS == 2) asm volatile("s_waitcnt vmcnt(2)\n\ts_barrier" : "+v"(qa), "+v"(qb_) :: "memory"); else asm volatile("s_waitcnt vmcnt(3)\n\ts_barrier" : "+v"(qa), "+v"(qb_) :: "memory");
        q8 = (v8i){(int)qa[0], (int)qa[1], (int)qa[2], (int)qa[3], (int)qb_[0], (int)qb_[1], (int)qb_[2], (int)qb_[3]};
    } else { const bf16* Qw = (const bf16*)Qp_ + (size_t)(qb * 256 + wid * 32) * 512;
#pragma unroll
        for (int d0 = 0; d0 < 4; ++d0) asm volatile("global_load_dwordx4 %0, %1, off" : "=v"(qr[d0]) : "v"(Qw + (size_t)r32 * 512 + d0 * 16 + hi * 8) : "memory");
        ATT_DMA(0, 0); ATT_DMA(1, 1);
        if (IPS == 2) asm volatile("s_waitcnt vmcnt(2)\n\ts_barrier" : "+v"(qr[0]), "+v"(qr[1]), "+v"(qr[2]), "+v"(qr[3]) :: "memory"); else asm volatile("s_waitcnt vmcnt(3)\n\ts_barrier" : "+v"(qr[0]), "+v"(qr[1]), "+v"(qr[2]), "+v"(qr[3]) :: "memory");
    }
    float mref = 0.f;
    f32x16 o[ND], osum = {}, negm = {}, SA0, SA1;
#pragma unroll
    for (int d = 0; d < ND; ++d) o[d] = f32x16{};
    v8i pa = {}; v4u pw[4] = {};
#define ATT_X(j) do { if (FQ) qkt8(SA0, SA1, shm + LDS_K + (j) * KSL, q8, negm, r32, hi); else qkt_c<false>(SA0, SA1, shm + LDS_K + (j) * KSL, qr, nullptr, negm, r32, hi); \
        soft_ref<ND>(SA0, SA1, negm, mref, o, osum, wsf, r32, hi, (j) == 0 && t == 0); \
        soft_exp<MASKED, FP>(SA0, SA1, MASKED ? *(const LAS u64*)(mring + (j) * 256 + r32 * 8) : 0ull, pa, pw, hi); } while (0)
#define ATT_Y(j) do { if (FP) pv8<ND>(o, osum, shm + LDS_V + (j) * VSL, (const LAS char*)(size_t)onesa, pa, r32, hi); else pv2<ND>(o, osum, vp0 + (j) * VSL, pw); } while (0)
#define ATT_STEP_A(j) do { const int tt = t + (j); if (tt + 2 < NT) ATT_DMA(tt + 2, ((j) + 2) & 3); \
        if (tt <= cq) { ATT_X(j); ATT_Y(j); } if (tt + 2 < NT) ATT_WAITN(IPS); else ATT_WAITN(0); } while (0)
    if (!STAG && wid >= 4) __builtin_amdgcn_s_setprio(1);
#define ATT_STEP_B(j) do { const int tt = t + (j); if (tt + 2 < NT) ATT_DMA(tt + 2, ((j) + 2) & 3); \
        if (tt > 0 && tt - 1 <= cq) ATT_Y(((j) + 3) & 3); if (tt <= cq) ATT_X(j); if (tt + 2 < NT) ATT_WAITN(IPS); else ATT_WAITN(0); } while (0)
    if (!STAG || wid < 4) { for (int t = 0; t < NT; t += 4) { ATT_STEP_A(0); ATT_STEP_A(1); ATT_STEP_A(2); ATT_STEP_A(3); } }
    else { for (int t = 0; t < NT; t += 4) { ATT_STEP_B(0); ATT_STEP_B(1); ATT_STEP_B(2); ATT_STEP_B(3); }
        if (NT - 1 <= cq) ATT_Y(3); }
    __builtin_amdgcn_s_setprio(0);
#undef ATT_STEP_B
#undef ATT_STEP_A
#undef ATT_WAITN
    asm volatile("s_waitcnt lgkmcnt(0)\n\ts_barrier" ::: "memory");
#undef ATT_X
#undef ATT_Y
#undef ATT_DMA
    float rli[16];
#pragma unroll
    for (int r = 0; r < 16; ++r) rli[r] = __builtin_amdgcn_rcpf(osum[r]);
    LAS bf16* stg = (LAS bf16*)(shm + LDS_OST) + wid * (32 * DV);
    const size_t orow0 = (size_t)(qb * 256 + wid * 32);
    if (OUT == 1) {
#pragma unroll
        for (int r = 0; r < 16; ++r)
#pragma unroll
            for (int d = 0; d < ND; ++d) O0s[(size_t)(wid * 32 + crow(r, hi)) * DV + d * 32 + r32] = o[d][r] * rli[r];
    } else {
        if (OUT == 2) {
            float gv[ND];
#pragma unroll
            for (int d = 0; d < ND; ++d) gv[d] = gsub[d * 32 + r32] * osc;
#pragma unroll
            for (int r = 0; r < 16; ++r) { float ss = 0.f;
#pragma unroll
                for (int d = 0; d < ND; ++d) { const float v = O0s[(size_t)(wid * 32 + crow(r, hi)) * DV + d * 32 + r32] - lam * (o[d][r] * rli[r]); o[d][r] = v; ss += v * v; }
#pragma unroll
                for (int x = 1; x < 32; x <<= 1) ss += __shfl_xor(ss, x);
                const float rs = __builtin_amdgcn_rsqf(ss * (1.0f / DV) + 1e-6f);
#pragma unroll
                for (int d = 0; d < ND; ++d) o[d][r] = o[d][r] * rs * gv[d]; }
#pragma unroll
            for (int r = 0; r < 16; ++r) rli[r] = 1.0f;
        }
#pragma unroll
        for (int r = 0; r < 16; ++r) { const int orow = crow(r, hi);
#pragma unroll
            for (int d = 0; d < ND; ++d) stg[orow * DV + d * 32 + r32] = (bf16)f2bf(o[d][r] * rli[r]); }
        LDS_WAIT();
        constexpr int CH = DV / 8, RPI = 64 / CH;
#pragma unroll
        for (int i = 0; i < 32 / RPI; ++i) { const int row = i * RPI + lane / CH, ch = lane % CH; const v4u v = *(const LAS v4u*)(stg + row * DV + ch * 8);
            *(v4u*)(Od + (orow0 + row) * 1024 + ch * 8) = v; }
    }
    asm volatile("s_waitcnt lgkmcnt(0)\n\ts_barrier" ::: "memory");
}
}

__device__ __forceinline__ void attention_phase(Frame& F0, const Inputs& I, int layer) {
    Frame F = F0; { int t_ = F0.tid; asm volatile("" : "+v"(t_)); F.tid = t_; F.lane = t_ & 63; F.wave = __builtin_amdgcn_readfirstlane(t_ >> 6); }
    const unsigned char* QKVb = F.ws + WS_QKV;
    bf16* MIX = (bf16*)(F.ws + WS_MIX); const GAS u64* MASK = (const GAS u64*)(F.ws + WS_MASK);
    LAS char* shm = (LAS char*)F.lds;
    static_assert(DIFF_Q1 && DIFF_FP, "the tile-major K / V^T layouts are written for this configuration (fp8 P.V, second component's QK^T on fp8)");
    const float lam_init = (layer == 0) ? 0.2f : 0.35550906759096926f;
    for (int v = F.vcu; v < 256; v += F.G) {
        { const int bh = v >> 3, b = bh >> 3, h = bh & 7, s = v & 7; const size_t ro = (size_t)b * T * 512 + h * 64;
#pragma unroll 1
          for (int i = 0; i < 4; ++i) { const int qb = (i == 0) ? s : (i == 1) ? 15 - s : (i == 2) ? 16 + s : 31 - s;
              { int t_ = F.tid; asm volatile("" : "+v"(t_)); F.lane = t_ & 63; F.wave = __builtin_amdgcn_readfirstlane(t_ >> 6); }
              att::attn_unit<64, true, 0, true, true, ATT_STAG_DSA>(shm, F.wave, F.lane, QKVb + pg8::QKV_Q8A + ro, QKVb + pg8::QKV_K8A + (size_t)(b * 8 + h) * 128 * 4096, QKVb + pg8::QKV_VT8A + (size_t)(b * 8 + h) * 128 * 4096, qb, MASK + (size_t)b * 128 * T, MIX + (size_t)b * T * 1024 + h * 64, nullptr, 0.f, 0.f, nullptr); } }
        { const int bh = v >> 4, b = bh >> 2, h = bh & 3, s = v & 15; float* O0s = (float*)(F.ws + WS_O0) + (size_t)blockIdx.x * (256 * 128);
          const float* gsub = I.g_subln + layer * 128;
          const float d1 = wave_sum(I.lq1[layer * 64 + F.lane] * I.lk1[layer * 64 + F.lane]), d2 = wave_sum(I.lq2[layer * 64 + F.lane] * I.lk2[layer * 64 + F.lane]);
          const float lam = __expf(d1) - __expf(d2) + lam_init;
#pragma unroll 1
          for (int i = 0; i < 2; ++i) { const int qb = (i == 0) ? s : 31 - s;
              const size_t r0 = (size_t)b * T * 512 + (2 * h) * 64, r1 = r0 + 64;
              const bf16* QB = (const bf16*)(QKVb + pg8::QKV_QB); const bf16* KB = (const bf16*)(QKVb + pg8::QKV_KB);
              const void* vsrc_ = DIFF_FP ? (const void*)(QKVb + pg8::QKV_VT8B + (size_t)(b * 4 + h) * 128 * 8192) : (const void*)((const bf16*)(QKVb + pg8::QKV_VB) + (size_t)b * T * 512 + h * 128);
              { int t_ = F.tid; asm volatile("" : "+v"(t_)); F.lane = t_ & 63; F.wave = __builtin_amdgcn_readfirstlane(t_ >> 6); }
              att::attn_unit<128, false, 1, false, DIFF_FP, ATT_STAG_DIFF>(shm, F.wave, F.lane, QB + r0, QKVb + pg8::QKV_KB + (size_t)(b * 4 + h) * 128 * 8192, vsrc_, qb, nullptr, nullptr, O0s, 0.f, 0.f, nullptr);
              { int t_ = F.tid; asm volatile("" : "+v"(t_)); F.lane = t_ & 63; F.wave = __builtin_amdgcn_readfirstlane(t_ >> 6); }
              if (DIFF_Q1 && DIFF_FP) att::attn_unit<128, false, 2, true, true, ATT_STAG_DIFF>(shm, F.wave, F.lane, F.ws + WS_Q8B + r1, F.ws + WS_K8B + (size_t)(b * 4 + h) * 128 * 4096, vsrc_, qb, nullptr, MIX + (size_t)b * T * 1024 + 512 + h * 128, O0s, lam, 1.0f - lam_init, gsub);
              else att::attn_unit<128, false, 2, false, DIFF_FP, ATT_STAG_DIFF>(shm, F.wave, F.lane, QB + r1, KB + r1, vsrc_, qb, nullptr, MIX + (size_t)b * T * 1024 + 512 + h * 128, O0s, lam, 1.0f - lam_init, gsub); } }
    }
}

struct Args { const float* in[14]; float* out; unsigned char* ws; };
__global__ void __launch_bounds__(NWAVES * 64, 2) fwd_kernel(Args args) {
    extern __shared__ __attribute__((aligned(16))) unsigned char lds[];
    Frame F;
    F.lds = (LAS unsigned char*)lds;
    F.MISC = (volatile LAS unsigned*)(F.lds + MISC_OFF);
    F.tid = threadIdx.x; F.lane = F.tid & 63; F.wave = __builtin_amdgcn_readfirstlane(F.tid >> 6);
    F.G = gridDim.x; { const int bx = blockIdx.x; F.vcu = (F.G % 8 == 0) ? (bx % 8) * (F.G / 8) + bx / 8 : bx; }
    F.ws = args.ws; F.ctl = (gu32*)(args.ws + WS_CTL);
    Inputs I; I.x = args.in[0]; I.w_in = args.in[1]; I.w_out = args.in[2]; I.g_mix = args.in[3]; I.lq1 = args.in[4]; I.lk1 = args.in[5]; I.lq2 = args.in[6]; I.lk2 = args.in[7];
    I.g_subln = args.in[8]; I.g_ffn = args.in[9]; I.w_gate = args.in[10]; I.w_up = args.in[11]; I.w_down = args.in[12]; I.g_final = args.in[13];
    for (int u = F.tid; u < (LDS_BYTES - LDSCTL_OFF) / 4; u += NWAVES * 64) ((LAS unsigned*)(F.lds + LDSCTL_OFF))[u] = 0u;
    __syncthreads();
    XcdBarrier bar = xcd_barrier_post((unsigned*)(F.ctl + CW_BAR), F.MISC + 8);
    u64* ssq = (u64*)(args.ws + WS_SSQ); bf16* XN = (bf16*)(args.ws + WS_XN); float* out = args.out;
#define GRID_BAR() do { XcdBarrier b_ = bar; asm volatile("" : "+s"(b_.x)); xcd_barrier(b_); } while (0)

    p0_prologue(F, I);
    GRID_BAR();
#pragma unroll 1
    for (int l = 0; l < NLAYER; ++l) {
        unsigned char* wl = args.ws + WS_W + (size_t)l * W_LAYER;
        {
            pg8::Gemm g{XN, (const bf16*)(wl + WO_IN), M, DINP, D}; pg8::StaticOrder S; S.init(M, DINP, F.G, (int)blockIdx.x);
            pg8::EpiIn E{ssq + (size_t)(2 * l) * M, (unsigned char*)(args.ws + WS_QKV), (bf16*)(args.ws + WS_IQ), (bf16*)(args.ws + WS_IK), (float*)(args.ws + WS_IW), (const float*)(args.ws + WS_CS64), (const float*)(args.ws + WS_CS32), args.ws + WS_Q8B, args.ws + WS_K8B};
            pg8::gemm_phase<pg8::EpiIn, pg8::StaticOrder, true, true>(F.lds, g, S, E);
        }
        GRID_BAR();
        select_phase(F, out);
        GRID_BAR();
        attention_phase(F, I, l);
        GRID_BAR();
        {
            pg8::Gemm g{(const bf16*)(args.ws + WS_MIX), (const bf16*)(wl + WO_OUT), M, D, D}; pg8::StaticOrder S; S.init(M, D, F.G, (int)blockIdx.x);
            pg8::EpiRes E{XN, ssq + (size_t)(2 * l + 1) * M};
            pg8::gemm_phase<pg8::EpiRes, pg8::StaticOrder, false, true>(F.lds, g, S, E);
        }
        GRID_BAR();
        {
            pg8::Gemm g{XN, (const bf16*)(wl + WO_GU), M, NGU, D}; pg8::StaticOrder S; S.init(M, NGU, F.G, (int)blockIdx.x);
            pg8::EpiGU E{ssq + (size_t)(2 * l + 1) * M, (bf16*)(args.ws + WS_H)};
            pg8::gemm_phase<pg8::EpiGU, pg8::StaticOrder, true, true>(F.lds, g, S, E);
        }
        GRID_BAR();
        {
            pg8::Gemm g{(const bf16*)(args.ws + WS_H), (const bf16*)(wl + WO_DN), M, D, DFF}; pg8::StaticOrder S; S.init(M, D, F.G, (int)blockIdx.x);
            pg8::EpiRes E{XN, ssq + (size_t)(2 * l + 2) * M};
            pg8::gemm_phase<pg8::EpiRes, pg8::StaticOrder, false, true>(F.lds, g, S, E);
        }
        GRID_BAR();
    }
    final_norm(F, out, XN, ssq + (size_t)4 * M, I.g_final);
}

extern "C" void kernel_launch(void* const* d_in, const int* in_sizes, int n_in, void* d_out, int out_size, void* d_ws, size_t ws_size, hipStream_t stream) {
    static int grid = 0;
    if (grid == 0) {
        if (n_in != 14 || in_sizes[0] != M * D || out_size != M * D || ws_size < WS_END) { fprintf(stderr, "kernel_launch: shape/workspace mismatch (n_in %d, in0 %d, out %d, ws %zu); nothing launched\n", n_in, n_in > 0 ? in_sizes[0] : -1, out_size, ws_size); grid = -1; return; }
        int dev = 0, cus = 0, per_cu = 0;
        if (hipGetDevice(&dev) != hipSuccess || hipDeviceGetAttribute(&cus, hipDeviceAttributeMultiprocessorCount, dev) != hipSuccess) { grid = -1; return; }
        if (hipFuncSetAttribute((const void*)fwd_kernel, hipFuncAttributeMaxDynamicSharedMemorySize, LDS_BYTES) != hipSuccess) { fprintf(stderr, "kernel_launch: hipFuncSetAttribute failed\n"); grid = -1; return; }
        if (hipOccupancyMaxActiveBlocksPerMultiprocessor(&per_cu, (const void*)fwd_kernel, NWAVES * 64, LDS_BYTES) != hipSuccess || per_cu < 1) fprintf(stderr, "kernel_launch: occupancy query reports %d\n", per_cu);
        (void)hipGetLastError();
        grid = cus;
    }
    if (grid < 0) return;
    if (hipMemsetAsync((char*)d_ws + WS_CTL, 0, CTL_ZERO_BYTES, stream) != hipSuccess) return;
    Args a{};
    for (int i = 0; i < 14; ++i) a.in[i] = (const float*)d_in[i];
    a.out = (float*)d_out; a.ws = (unsigned char*)d_ws;
    hipLaunchKernelGGL(fwd_kernel, dim3(grid), dim3(NWAVES * 64), LDS_BYTES, stream, a);
}
```

```cpp
#include <hip/hip_runtime.h>
#include <cstdio>
#include <cstdint>
#ifndef ATT_STAG_DIFF
#define ATT_STAG_DIFF true
#endif
#ifndef ATT_STAG_DSA
#define ATT_STAG_DSA true
#endif
#ifndef DIFF_Q1
#define DIFF_Q1 true
#endif
#ifndef DIFF_FP
#define DIFF_FP true
#endif
namespace pg8 {
#define PG8_LAS __attribute__((address_space(3)))
typedef unsigned short bf16_t;
typedef short bf16x8 __attribute__((ext_vector_type(8)));
typedef float f32x4 __attribute__((ext_vector_type(4)));
typedef unsigned u32x4 __attribute__((ext_vector_type(4)));
constexpr int BM = 256, BK = 64, HALF = 128, HTB = HALF * BK * 2  , STAGE_BYTES = 8 * HTB, NXCD = 8, WGM = 8;

__host__ __device__ __forceinline__ int lds_byte(int r, int c) { const int st = (r >> 4) * 2 + (c >> 5), rr = r & 15, cc = c & 31, ob = rr * 64 + cc * 2; return st * 1024 + (ob ^ (((ob >> 9) & 1) << 5)); }
__host__ __device__ __forceinline__ void stage_rc(int b, int& R, int& C) { const int st = b / 1024, sb = b % 1024, swz = sb ^ (((sb >> 9) & 1) << 5); R = (st >> 1) * 16 + swz / 64; C = (st & 1) * 32 + (swz % 64) / 2; }
__host__ __device__ __forceinline__ int perm32(int rho) { const int n = rho >> 4, i = rho & 15; return 8 * (i >> 2) + 4 * n + (i & 3); }

struct Unit { int pm, pn; };
struct Gemm { const bf16_t* A; const bf16_t* Bt; int M, N, K; };

struct StaticOrder {
    int nM, nN, nwg, G, c;
    __host__ __device__ void init(int M, int N, int G_, int c_) { nM = M / BM; nN = N / BM; nwg = nM * nN; G = G_; c = c_; }
    __host__ __device__ bool next(int i, Unit& u) const {
        const long L = (long)i * G + c; if (L >= nwg) return false;
        int wgid = (int)L; { const int q = nwg / NXCD, r = nwg % NXCD, xcd = wgid % NXCD, off = wgid / NXCD; wgid = (xcd < r ? xcd * (q + 1) : r * (q + 1) + (xcd - r) * q) + off; }
        const int nig = WGM * nN, gid = wgid / nig, fm = gid * WGM, gsz = (nM - fm) < WGM ? (nM - fm) : WGM;
        u.pm = fm + ((wgid % nig) % gsz); u.pn = (wgid % nig) / gsz; return true;
    }
    __device__ __forceinline__ void a_ready(const Unit&) const {}
    __device__ __forceinline__ void done(const Unit&) const {}
};

__device__ __forceinline__ unsigned cvt_pk_bf16(float lo, float hi) { unsigned r; asm volatile("v_cvt_pk_bf16_f32 %0, %1, %2" : "=v"(r) : "v"(lo), "v"(hi)); return r; }
__device__ __forceinline__ u32x4 pack8(const f32x4 a, const f32x4 b) { u32x4 w; w.x = cvt_pk_bf16(a[0], a[1]); w.y = cvt_pk_bf16(a[2], a[3]); w.z = cvt_pk_bf16(b[0], b[1]); w.w = cvt_pk_bf16(b[2], b[3]); return w; }
constexpr float RMS_EPS_F = 1e-6f;
constexpr float QK_C2 = 0.125f * 1.4426950408889634f;
constexpr size_t QKV_Q8A = 0, QKV_K8A = (size_t)16 << 20, QKV_VA = (size_t)32 << 20, QKV_QB = (size_t)64 << 20, QKV_KB = (size_t)96 << 20, QKV_VB = (size_t)128 << 20, QKV_VT8A = (size_t)160 << 20, QKV_VT8B = (size_t)176 << 20;

__device__ __forceinline__ size_t k8_tile_off(int row, int nheads, int h, int dim) { const int b = row >> 13, t = row & 8191;
    return ((((size_t)(b * nheads + h) * 128 + (t >> 6)) * 4 + (dim >> 4)) * 64 + (t & 63)) * 16 + (dim & 8); }
__device__ __forceinline__ size_t kb_tile_off(int row, int h, int dim) { const int b = row >> 13, t = row & 8191;
    return ((((size_t)(b * 4 + h) * 128 + (t >> 6)) * 8 + (dim >> 3)) * 64 + (t & 63)) * 16; }
struct EpiIn {
    static constexpr bool PERM = true, AFTER_DRAIN = false;
    const unsigned long long* ssq; unsigned char* qkv; bf16_t* IQ; bf16_t* IK; float* IW; const float* cs64; const float* cs32; unsigned char* q8b; unsigned char* k8b;
    __device__ __forceinline__ void operator()(const f32x4 (&acc)[2][2][4][2], const Unit& u, int wr, int wc, int fr_, int fq_) const {
        int fr = fr_, fq = fq_; asm volatile("" : "+v"(fr), "+v"(fq));
        const int pn = u.pn; const int row0 = u.pm * BM + wr * 64 + fr;
        const int kind = pn >> 1;
        const bool rope64 = pn < 12 && kind != 2 && kind != 5, rope32 = pn == 12 || (pn == 13 && wc == 0);
        const float* tab = rope64 ? cs64 + (4 * (wc & 1) + fq) * 8 : cs32 + fq * 8; const int tstride = rope64 ? 64 : 32;
#pragma unroll
        for (int ai = 0; ai < 2; ++ai) {
            float rs[4]; f32x4 c4[4], s4[4];
#pragma unroll
            for (int m = 0; m < 4; ++m) { const int row = row0 + ai * HALF + m * 16; rs[m] = (float)ssq[row] * (1.0f / 1048576.0f);
                if (rope64 || rope32) { const float* tp = tab + (size_t)(row & 8191) * tstride; c4[m] = *(const f32x4*)tp; s4[m] = *(const f32x4*)(tp + 4); } else { c4[m] = (f32x4){1.f, 1.f, 1.f, 1.f}; s4[m] = (f32x4){0.f, 0.f, 0.f, 0.f}; } }
#pragma unroll
            for (int m = 0; m < 4; ++m) {
                const int row = row0 + ai * HALF + m * 16;
                const float r = __builtin_amdgcn_rsqf(rs[m] * (1.0f / 1024.0f) + RMS_EPS_F);
                if (pn < 12) {
                    const size_t coff = (size_t)row * 512 + (pn & 1) * 256 + wc * 32 + 8 * fq;
                    if (kind == 2 || kind == 5) {
                        unsigned char* dst = qkv + (kind == 2 ? QKV_VA : QKV_VB) + coff;
#pragma unroll
                        for (int bj = 0; bj < 2; ++bj) { const f32x4 y1 = acc[ai][bj][m][0] * r, y2 = acc[ai][bj][m][1] * r;
                            int w0 = 0, w1 = 0; w0 = __builtin_amdgcn_cvt_pk_fp8_f32(y1[0], y1[1], w0, false); w0 = __builtin_amdgcn_cvt_pk_fp8_f32(y1[2], y1[3], w0, true);
                            w1 = __builtin_amdgcn_cvt_pk_fp8_f32(y2[0], y2[1], w1, false); w1 = __builtin_amdgcn_cvt_pk_fp8_f32(y2[2], y2[3], w1, true);
                            *(unsigned long long*)(dst + bj * HALF) = (unsigned long long)(unsigned)w0 | ((unsigned long long)(unsigned)w1 << 32); }
                    } else if (kind >= 3 && (!DIFF_Q1 || wc < 2)) {
                        const float sc = (kind == 3) ? r * QK_C2 : r;
#pragma unroll
                        for (int bj = 0; bj < 2; ++bj) { const f32x4 x1 = acc[ai][bj][m][0] * sc, x2 = acc[ai][bj][m][1] * sc;
                            bf16_t* dst = (kind == 3) ? (bf16_t*)(qkv + QKV_QB) + coff + bj * HALF
                                                      : (bf16_t*)(qkv + QKV_KB + kb_tile_off(row, 2 * (pn & 1) + bj, wc * 32 + 8 * fq));
                            *(u32x4*)dst = pack8(x1 * c4[m] - x2 * s4[m], x2 * c4[m] + x1 * s4[m]); }
                    } else {
                        const float sc = (kind == 0 || kind == 3) ? r * (QK_C2 * 8.0f) : r;
#pragma unroll
                        for (int bj = 0; bj < 2; ++bj) { const f32x4 x1 = acc[ai][bj][m][0] * sc, x2 = acc[ai][bj][m][1] * sc;
                            const f32x4 y1 = x1 * c4[m] - x2 * s4[m], y2 = x2 * c4[m] + x1 * s4[m];
                            int w0 = 0, w1 = 0; w0 = __builtin_amdgcn_cvt_pk_fp8_f32(y1[0], y1[1], w0, false); w0 = __builtin_amdgcn_cvt_pk_fp8_f32(y1[2], y1[3], w0, true);
                            w1 = __builtin_amdgcn_cvt_pk_fp8_f32(y2[0], y2[1], w1, false); w1 = __builtin_amdgcn_cvt_pk_fp8_f32(y2[2], y2[3], w1, true);
                            const int pc = (pn & 1) * 256 + bj * HALF + wc * 32 + 8 * fq;
                            unsigned char* dst = (kind == 0) ? qkv + QKV_Q8A + coff + bj * HALF : (kind == 3) ? q8b + coff + bj * HALF
                                               : (kind == 1) ? qkv + QKV_K8A + k8_tile_off(row, 8, pc >> 6, pc & 63) : k8b + k8_tile_off(row, 4, pc >> 7, (pc & 127) - 64);
                            *(unsigned long long*)dst = (unsigned long long)(unsigned)w0 | ((unsigned long long)(unsigned)w1 << 32); }
                    }
                } else if (pn == 12) {
#pragma unroll
                    for (int bj = 0; bj < 2; ++bj) { const f32x4 x1 = acc[ai][bj][m][0] * r, x2 = acc[ai][bj][m][1] * r;
                        *(u32x4*)(IQ + (size_t)row * 256 + bj * HALF + wc * 32 + 8 * fq) = pack8(x1 * c4[m] - x2 * s4[m], x2 * c4[m] + x1 * s4[m]); }
                } else {
                    if (wc == 0) {
                        const f32x4 x1 = acc[ai][0][m][0] * r, x2 = acc[ai][0][m][1] * r;
                        *(u32x4*)(IK + (size_t)row * 32 + 8 * fq) = pack8(x1 * c4[m] - x2 * s4[m], x2 * c4[m] + x1 * s4[m]);
                    } else if (wc == 1 && fq == 0) {
                        *(f32x4*)(IW + (size_t)row * 8) = acc[ai][0][m][0] * r; *(f32x4*)(IW + (size_t)row * 8 + 4) = acc[ai][0][m][1] * r;
                    }
                }
            }
            asm volatile("" ::: "memory");
        }
    }
};

struct EpiRes {
    static constexpr bool PERM = true, AFTER_DRAIN = false;
    bf16_t* xn; unsigned long long* ssq_out;
    __device__ __forceinline__ void operator()(const f32x4 (&acc)[2][2][4][2], const Unit& u, int wr, int wc, int fr_, int fq_) const {
        int fr = fr_, fq = fq_; asm volatile("" : "+v"(fr), "+v"(fq));
        const int row0 = u.pm * BM + wr * 64 + fr; const int col0 = u.pn * BM + wc * 32 + 8 * fq;
#pragma unroll
        for (int ai = 0; ai < 2; ++ai) {
            u32x4 xi[4][2];
#pragma unroll
            for (int m = 0; m < 4; ++m)
#pragma unroll
                for (int bj = 0; bj < 2; ++bj) xi[m][bj] = *(const u32x4*)(xn + (size_t)(row0 + ai * HALF + m * 16) * 1024 + col0 + bj * HALF);
#pragma unroll
            for (int m = 0; m < 4; ++m) {
                const int row = row0 + ai * HALF + m * 16; float part = 0.f;
#pragma unroll
                for (int bj = 0; bj < 2; ++bj) { const size_t off = (size_t)row * 1024 + col0 + bj * HALF; const u32x4 w = xi[m][bj];
                    const f32x4 x0 = {__uint_as_float(w.x << 16), __uint_as_float(w.x & 0xffff0000u), __uint_as_float(w.y << 16), __uint_as_float(w.y & 0xffff0000u)};
                    const f32x4 x1 = {__uint_as_float(w.z << 16), __uint_as_float(w.z & 0xffff0000u), __uint_as_float(w.w << 16), __uint_as_float(w.w & 0xffff0000u)};
                    const f32x4 o0 = x0 + acc[ai][bj][m][0], o1 = x1 + acc[ai][bj][m][1];
                    *(u32x4*)(xn + off) = pack8(o0, o1);
                    part += (o0[0] * o0[0] + o0[1] * o0[1]) + (o0[2] * o0[2] + o0[3] * o0[3]) + (o1[0] * o1[0] + o1[1] * o1[1]) + (o1[2] * o1[2] + o1[3] * o1[3]); }
                part += __shfl_xor(part, 16); part += __shfl_xor(part, 32);
                if (fq == 0) __hip_atomic_fetch_add(ssq_out + row, (unsigned long long)(part * 1048576.0f), __ATOMIC_RELAXED, __HIP_MEMORY_SCOPE_AGENT);
            }
            asm volatile("" ::: "memory");
        }
    }
};

struct EpiGU {
    static constexpr bool PERM = true, AFTER_DRAIN = false;
    const unsigned long long* ssq; bf16_t* H;
    __device__ __forceinline__ void operator()(const f32x4 (&acc)[2][2][4][2], const Unit& u, int wr, int wc, int fr_, int fq_) const {
        int fr = fr_, fq = fq_; asm volatile("" : "+v"(fr), "+v"(fq));
        const int row0 = u.pm * BM + wr * 64 + fr; const int col0 = u.pn * HALF + wc * 32 + 8 * fq;
        float rsv[2][4];
#pragma unroll
        for (int ai = 0; ai < 2; ++ai)
#pragma unroll
            for (int m = 0; m < 4; ++m) rsv[ai][m] = (float)ssq[row0 + ai * HALF + m * 16] * (1.0f / 1048576.0f);
#pragma unroll
        for (int ai = 0; ai < 2; ++ai)
#pragma unroll
            for (int m = 0; m < 4; ++m) {
                const int row = row0 + ai * HALF + m * 16;
                const float rs = __builtin_amdgcn_rsqf(rsv[ai][m] * (1.0f / 1024.0f) + RMS_EPS_F);
                f32x4 h[2];
#pragma unroll
                for (int n = 0; n < 2; ++n) { const f32x4 g = acc[ai][0][m][n] * rs, up = acc[ai][1][m][n] * rs;
#pragma unroll
                    for (int i = 0; i < 4; ++i) h[n][i] = g[i] * __builtin_amdgcn_rcpf(1.0f + __builtin_amdgcn_exp2f(g[i] * -1.4426950408889634f)) * up[i]; }
                *(u32x4*)(H + (size_t)row * 2816 + col0) = pack8(h[0], h[1]);
            }
    }
};

template <class Epi, class Sched, bool ALIGN_EPI = false, bool SP2 = false>
__device__ __forceinline__ void gemm_phase(PG8_LAS unsigned char* lds, const Gemm g, const Sched& S, const Epi& E) {
    int tid_ = threadIdx.x; asm volatile("" : "+v"(tid_));
    const int tid = tid_, wid = __builtin_amdgcn_readfirstlane(tid >> 6), lane = tid & 63, wr = wid >> 2, wc = wid & 3, fr = lane & 15, fq = lane >> 4;
    const int K = g.K, nt = K / BK;
    unsigned voffA[2], voffB[2];
#pragma unroll
    for (int i = 0; i < 2; ++i) { int R, C; stage_rc(tid * 16 + i * 8192, R, C); const int Rb = Epi::PERM ? ((R & ~31) + perm32(R & 31)) : R;
        voffA[i] = (unsigned)(R * K + C) * 2u; voffB[i] = (unsigned)(Rb * K + C) * 2u; }
    const size_t kstep = (size_t)(BK * 2);
    const size_t hstep = (size_t)HALF * K * 2;
    const size_t tstep = 2 * hstep;
    const unsigned ldsw = (unsigned)wid * 1024u;
    const int aoff = lds_byte(wr * 64 + fr, fq * 8), boff = lds_byte(wc * 32 + fr, fq * 8);
#define PG8_SA(b, h) (((b) * 2 + (h)) * HTB)
#define PG8_SB(b, h) ((4 + (b) * 2 + (h)) * HTB)
#define PG8_STAGE(bufoff, gbase, voff) do { _Pragma("unroll") for (int _i = 0; _i < 2; ++_i) \
        __builtin_amdgcn_global_load_lds((const unsigned*)((const char*)(gbase) + (voff)[_i]), (PG8_LAS unsigned*)(lds + (bufoff) + ldsw + _i * 8192), 16, 0, 0); } while (0)
#define PG8_LDA(dst, b, h) do { _Pragma("unroll") for (int m = 0; m < 4; ++m) _Pragma("unroll") for (int k = 0; k < 2; ++k) dst[m][k] = *(const PG8_LAS bf16x8*)(lds + PG8_SA(b, h) + aoff + m * 2048 + k * 1024); } while (0)
#define PG8_LDB(dst, b, h) do { _Pragma("unroll") for (int n = 0; n < 2; ++n) _Pragma("unroll") for (int k = 0; k < 2; ++k) dst[n][k] = *(const PG8_LAS bf16x8*)(lds + PG8_SB(b, h) + boff + n * 2048 + k * 1024); } while (0)
#define PG8_MMA(ai, bj, At, Bt) do { __builtin_amdgcn_s_setprio(1); _Pragma("unroll") for (int m = 0; m < 4; ++m) _Pragma("unroll") for (int n = 0; n < 2; ++n) _Pragma("unroll") for (int k = 0; k < 2; ++k) \
        acc[ai][bj][m][n] = __builtin_amdgcn_mfma_f32_16x16x32_bf16(Bt[n][k], At[m][k], acc[ai][bj][m][n], 0, 0, 0); __builtin_amdgcn_s_setprio(0); } while (0)
#define PG8_WAIT_V(n) asm volatile("s_waitcnt vmcnt(" #n ")" ::: "memory")
#define PG8_WAIT_L(n) asm volatile("s_waitcnt lgkmcnt(" #n ")" ::: "memory")
#define PG8_BAR __builtin_amdgcn_s_barrier()
#define PG8_SCHED __builtin_amdgcn_sched_barrier(0)
    Unit cur, nxt; int ui = 0;
    if (!S.next(0, cur)) return;
    f32x4 acc[2][2][4][2];
#pragma unroll
    for (int a = 0; a < 2; ++a)
#pragma unroll
        for (int b = 0; b < 2; ++b)
#pragma unroll
            for (int m = 0; m < 4; ++m)
#pragma unroll
                for (int n = 0; n < 2; ++n) acc[a][b][m][n] = (f32x4){0.f, 0.f, 0.f, 0.f};
    bf16x8 At[4][2], B0[2][2], B1[2][2];
    const char* cA = (const char*)g.A + (size_t)cur.pm * tstep; const char* cB = (const char*)g.Bt + (size_t)cur.pn * tstep;
    S.a_ready(cur);
    if constexpr (SP2) {
        PG8_STAGE(PG8_SB(0, 0), cB, voffB); PG8_STAGE(PG8_SB(0, 1), cB + hstep, voffB); PG8_STAGE(PG8_SA(0, 0), cA, voffA); PG8_STAGE(PG8_SA(0, 1), cA + hstep, voffA);
        if (wr == 1) PG8_BAR;
        PG8_WAIT_V(2); PG8_BAR;
        PG8_STAGE(PG8_SB(1, 0), cB + kstep, voffB); PG8_STAGE(PG8_SA(1, 0), cA + kstep, voffA); PG8_STAGE(PG8_SB(1, 1), cB + hstep + kstep, voffB);
        PG8_WAIT_V(6); PG8_BAR;
    } else {
        PG8_STAGE(PG8_SB(0, 0), cB, voffB); PG8_STAGE(PG8_SA(0, 0), cA, voffA); PG8_STAGE(PG8_SB(0, 1), cB + hstep, voffB); PG8_STAGE(PG8_SA(0, 1), cA + hstep, voffA);
        if (wr == 1) PG8_BAR;
        PG8_WAIT_V(4); PG8_BAR;
        PG8_STAGE(PG8_SB(1, 0), cB + kstep, voffB); PG8_STAGE(PG8_SA(1, 0), cA + kstep, voffA); PG8_STAGE(PG8_SB(1, 1), cB + hstep + kstep, voffB);
        PG8_WAIT_V(6); PG8_BAR;
    }
    for (;;) {
        const bool has_next = S.next(ui + 1, nxt);
        const char* nA = has_next ? (const char*)g.A + (size_t)nxt.pm * tstep : cA; const char* nB = has_next ? (const char*)g.Bt + (size_t)nxt.pn * tstep : cB;
        for (int t = 0; t < nt; t += 2) {
            const bool last = (t == nt - 2);
            const char* a1 = cA + (size_t)(t + 1) * kstep;
            const char* a2 = last ? nA : cA + (size_t)(t + 2) * kstep; const char* b2 = last ? nB : cB + (size_t)(t + 2) * kstep;
            const char* a3 = a2 + kstep; const char* b3 = b2 + kstep;
            if (last && has_next) S.a_ready(nxt);
            if constexpr (SP2) {
            PG8_LDB(B0, 0, 0); PG8_LDB(B1, 0, 1); PG8_SCHED; PG8_LDA(At, 0, 0); PG8_STAGE(PG8_SA(1, 1), a1 + hstep, voffA);
            PG8_WAIT_V(8); PG8_WAIT_L(0); PG8_BAR; PG8_MMA(0, 0, At, B0); PG8_MMA(0, 1, At, B1); PG8_BAR; PG8_SCHED;
            PG8_LDA(At, 0, 1); PG8_STAGE(PG8_SB(0, 0), b2, voffB); PG8_STAGE(PG8_SB(0, 1), b2 + hstep, voffB); PG8_STAGE(PG8_SA(0, 0), a2, voffA);
            PG8_WAIT_V(8); PG8_WAIT_L(0); PG8_BAR; PG8_MMA(1, 0, At, B0); PG8_MMA(1, 1, At, B1); PG8_BAR; PG8_SCHED;
            PG8_LDB(B0, 1, 0); PG8_LDB(B1, 1, 1); PG8_SCHED; PG8_LDA(At, 1, 0); PG8_STAGE(PG8_SA(0, 1), a2 + hstep, voffA);
            PG8_WAIT_V(8); PG8_WAIT_L(0); PG8_BAR; PG8_MMA(0, 0, At, B0); PG8_MMA(0, 1, At, B1); PG8_BAR; PG8_SCHED;
            PG8_LDA(At, 1, 1); PG8_STAGE(PG8_SB(1, 0), b3, voffB); PG8_STAGE(PG8_SB(1, 1), b3 + hstep, voffB); PG8_STAGE(PG8_SA(1, 0), a3, voffA);
            PG8_WAIT_V(8); PG8_WAIT_L(0); PG8_BAR; PG8_MMA(1, 0, At, B0); PG8_MMA(1, 1, At, B1); PG8_BAR; PG8_SCHED;
            } else {
            PG8_LDB(B0, 0, 0); PG8_SCHED; PG8_LDA(At, 0, 0); PG8_STAGE(PG8_SA(1, 1), a1 + hstep, voffA);
            PG8_WAIT_L(8); PG8_BAR; PG8_WAIT_L(0); PG8_MMA(0, 0, At, B0); PG8_BAR; PG8_SCHED;
            PG8_LDB(B1, 0, 1); PG8_STAGE(PG8_SB(0, 0), b2, voffB);
            PG8_BAR; PG8_WAIT_L(0); PG8_MMA(0, 1, At, B1); PG8_BAR;
            PG8_LDA(At, 0, 1); PG8_STAGE(PG8_SA(0, 0), a2, voffA);
            PG8_BAR; PG8_WAIT_L(0); PG8_MMA(1, 0, At, B0); PG8_BAR; PG8_SCHED;
            PG8_STAGE(PG8_SB(0, 1), b2 + hstep, voffB);
            PG8_WAIT_V(6); PG8_BAR; PG8_MMA(1, 1, At, B1); PG8_BAR;
            PG8_LDB(B0, 1, 0); PG8_SCHED; PG8_LDA(At, 1, 0); PG8_STAGE(PG8_SA(0, 1), a2 + hstep, voffA);
            PG8_WAIT_L(8); PG8_BAR; PG8_WAIT_L(0); PG8_MMA(0, 0, At, B0); PG8_BAR; PG8_SCHED;
            PG8_LDB(B1, 1, 1); PG8_STAGE(PG8_SB(1, 0), b3, voffB);
            PG8_BAR; PG8_WAIT_L(0); PG8_MMA(0, 1, At, B1); PG8_BAR;
            PG8_LDA(At, 1, 1); PG8_STAGE(PG8_SA(1, 0), a3, voffA);
            PG8_BAR; PG8_WAIT_L(0); PG8_MMA(1, 0, At, B0); PG8_BAR; PG8_SCHED;
            PG8_STAGE(PG8_SB(1, 1), b3 + hstep, voffB);
            PG8_WAIT_V(6); PG8_BAR; PG8_MMA(1, 1, At, B1); PG8_BAR;
            }
        }
        if constexpr (ALIGN_EPI) { if (wr == 0) PG8_BAR; }
        if constexpr (!Epi::AFTER_DRAIN) { E(acc, cur, wr, wc, fr, fq); S.done(cur); }
        if (!has_next) break;
#pragma unroll
        for (int a = 0; a < 2; ++a)
#pragma unroll
            for (int b = 0; b < 2; ++b)
#pragma unroll
                for (int m = 0; m < 4; ++m)
#pragma unroll
                    for (int n = 0; n < 2; ++n) acc[a][b][m][n] = (f32x4){0.f, 0.f, 0.f, 0.f};
        cur = nxt; cA = nA; cB = nB; ++ui;
        if constexpr (ALIGN_EPI) { if (wr == 1) PG8_BAR; }
    }
    PG8_WAIT_V(0);
    if constexpr (!ALIGN_EPI) { if (wr == 0) PG8_BAR; }
    PG8_BAR;
    if constexpr (Epi::AFTER_DRAIN) { E.fused(acc, cur, wr, wc, fr, fq, lds, wid, lane); S.done(cur); }
#undef PG8_SA
#undef PG8_SB
#undef PG8_STAGE
#undef PG8_LDA
#undef PG8_LDB
#undef PG8_MMA
#undef PG8_WAIT_V
#undef PG8_WAIT_L
#undef PG8_BAR
#undef PG8_SCHED
}
}
constexpr int NWAVES = 8;
constexpr int NB = 4, T = 8192, M = NB * T, D = 1024, DINP = 3584, DIN_SRC = 3368, DFF = 2816, NGU = 2 * DFF, NLAYER = 2;
constexpr size_t MiB = 1u << 20;
constexpr size_t WS_CTL = 0, CTL_ZERO_BYTES = 2 * MiB;
constexpr size_t WS_SSQ = 768 * 1024;
constexpr float SSQ_FIX = 1048576.0f, SSQ_UNFIX = 1.0f / 1048576.0f;
constexpr size_t WS_W = 2 * MiB, W_LAYER = 26 * MiB;
constexpr size_t WO_IN = 0, WO_OUT = 7 * MiB, WO_GU = 9 * MiB, WO_DN = 20 * MiB;
constexpr size_t WS_CS64 = 54 * MiB, WS_CS32 = 56 * MiB;
constexpr size_t WS_XN = 64 * MiB;
constexpr size_t WS_QKV = 128 * MiB;
constexpr size_t WS_H = 128 * MiB;
constexpr size_t WS_IQ = 320 * MiB, WS_IK = 336 * MiB, WS_IW = 338 * MiB;
constexpr size_t WS_MASK = 340 * MiB;
constexpr size_t WS_MIX = 372 * MiB;
constexpr size_t WS_O0 = 436 * MiB;
constexpr size_t WS_Q8B = 468 * MiB, WS_K8B = 484 * MiB;
constexpr size_t WS_END = 500 * MiB;
static_assert(WS_W + 2 * W_LAYER <= WS_CS64 && WS_H + (size_t)M * DFF * 2 <= WS_IQ && WS_O0 + (size_t)256 * 256 * 128 * 4 <= WS_END, "d_ws map");
constexpr int CW_BAR = 4096;
constexpr int RING_BYTES = 131072, LDSCTL_OFF = RING_BYTES, MISC_OFF = LDSCTL_OFF + 320, LDS_BYTES = 147456;

#define GAS __attribute__((address_space(1)))
#define LAS __attribute__((address_space(3)))
typedef unsigned short bf16;
typedef unsigned v4u __attribute__((ext_vector_type(4)));
typedef float f32x4 __attribute__((ext_vector_type(4)));
typedef float f32x16 __attribute__((ext_vector_type(16)));
typedef short bf16x8 __attribute__((ext_vector_type(8)));
typedef short s16x4 __attribute__((ext_vector_type(4)));
typedef GAS unsigned gu32;
typedef unsigned long long u64;
#define RLX_AGENT __ATOMIC_RELAXED, __HIP_MEMORY_SCOPE_AGENT
#define LDS_WAIT() asm volatile("s_waitcnt lgkmcnt(0)" ::: "memory")
#define VM_WAIT() asm volatile("s_waitcnt vmcnt(0)" ::: "memory")
__device__ __forceinline__ unsigned f2bf(float f) { unsigned u = __builtin_bit_cast(unsigned, f); return (u + 0x7fffu + ((u >> 16) & 1u)) >> 16; }
__device__ __forceinline__ unsigned pk2(float lo, float hi) { return f2bf(lo) | (f2bf(hi) << 16); }
#define XB_TMO      128
#define XB_XCNT(j)  (256  + 64 * (j))
#define XB_XSUB(j)  (1280 + 64 * (j))
#define XB_XGEN(j)  (2304 + 64 * (j))
#define XB_TOP      3328
#define XB_TOPGEN   3392
#define XCD_BAR_WORDS 3456
#define XB_SPIN_CAP (1u << 18)

__device__ __forceinline__ unsigned xb_ld(unsigned* p)              { return __hip_atomic_load(p, __ATOMIC_RELAXED, __HIP_MEMORY_SCOPE_AGENT); }
__device__ __forceinline__ unsigned xb_add(unsigned* p, unsigned v) { return __hip_atomic_fetch_add(p, v, __ATOMIC_RELAXED, __HIP_MEMORY_SCOPE_AGENT); }
__device__ __forceinline__ unsigned xb_xcc_id() { return (unsigned)__builtin_amdgcn_s_getreg((3 << 11) | 20) & 0xFu; }
#define XB_SPIN(cond, bar) do { unsigned _sp = 0; while (cond) { __builtin_amdgcn_s_sleep(1); \
    if ((++_sp & 255u) == 0u) { if (xb_ld(&(bar)[XB_TMO])) break; if (_sp > XB_SPIN_CAP) { atomicAdd(&(bar)[XB_TMO], 1u); break; } } } } while (0)

struct XcdBarrier {
    unsigned* bar; unsigned x;
    volatile LAS unsigned* st;
};

__device__ __forceinline__ XcdBarrier xcd_barrier_post(unsigned* bar, volatile LAS unsigned* st) {
    XcdBarrier b; b.bar = bar; b.x = xb_xcc_id(); b.st = st;
    if (threadIdx.x == 0) (void)xb_add(&bar[XB_XCNT(b.x)], 1u);
    return b;
}
__device__ __forceinline__ void xcd_barrier_complete(unsigned* bar, unsigned x, unsigned& nloc, unsigned& nx) {
    const unsigned G = gridDim.x * gridDim.y * gridDim.z;
    unsigned sum, cnt, mine, sp = 0u;
    for (;;) {
        sum = 0u; cnt = 0u; mine = 0u;
#pragma unroll
        for (unsigned j = 0; j < 16; ++j) { const unsigned c = xb_ld(&bar[XB_XCNT(j)]); sum += c; cnt += (c > 0u) ? 1u : 0u; mine = (j == x) ? c : mine; }
        if (sum == G) break;
        __builtin_amdgcn_s_sleep(1);
        if ((++sp & 255u) == 0u) { if (xb_ld(&bar[XB_TMO])) break; if (sp > XB_SPIN_CAP) { atomicAdd(&bar[XB_TMO], 1u); break; } }
    }
    nloc = mine > 0u ? mine : 1u; nx = cnt > 0u ? cnt : 1u;
}

__device__ __forceinline__ void xcd_barrier(const XcdBarrier& b) {
    asm volatile("s_waitcnt vmcnt(0)" ::: "memory");
    __syncthreads();
    if (threadIdx.x == 0) {
        unsigned* bar = b.bar;
        __builtin_amdgcn_s_waitcnt(0);
        unsigned nloc = b.st[0], nx = b.st[1];
        if (nloc == 0u) { xcd_barrier_complete(bar, b.x, nloc, nx); b.st[0] = nloc; b.st[1] = nx; }
        const unsigned old = xb_add(&bar[XB_XSUB(b.x)], 1u);
        const unsigned gen = old / nloc;
        if (old + 1u == (gen + 1u) * nloc) {
            __builtin_amdgcn_fence(__ATOMIC_RELEASE, "agent");
            asm volatile("s_waitcnt vmcnt(0)" ::: "memory");
            const unsigned og = xb_add(&bar[XB_TOP], 1u);
            const unsigned tg = og / nx;
            if (og + 1u == (tg + 1u) * nx) xb_add(&bar[XB_TOPGEN], 1u);
            else XB_SPIN(xb_ld(&bar[XB_TOPGEN]) == tg, bar);
            __builtin_amdgcn_fence(__ATOMIC_ACQUIRE, "agent");
            xb_add(&bar[XB_XGEN(b.x)], 1u);
            asm volatile("s_waitcnt vmcnt(0)" ::: "memory");
        } else {
            XB_SPIN(xb_ld(&bar[XB_XGEN(b.x)]) == gen, bar);
            __builtin_amdgcn_fence(__ATOMIC_ACQUIRE, "agent");
            asm volatile("s_waitcnt vmcnt(0)" ::: "memory");
        }
    }
    __syncthreads();
}
struct Frame {
    LAS unsigned char* lds;
    volatile LAS unsigned* MISC;
    gu32* ctl;
    int tid, lane, wave;
    int vcu, G;
    unsigned char* ws;
};
__device__ __forceinline__ float wave_sum(float v) {
#pragma unroll
    for (int o = 1; o < 64; o <<= 1) v += __shfl_xor(v, o);
    return v;
}
__device__ const float INV64[32] = {1.000000000e+00f, 7.498942614e-01f, 5.623413324e-01f, 4.216965139e-01f, 3.162277639e-01f, 2.371373773e-01f, 1.778279394e-01f, 1.333521307e-01f, 1.000000015e-01f, 7.498941571e-02f, 5.623413250e-02f, 4.216965288e-02f, 3.162277490e-02f, 2.371373773e-02f, 1.778279431e-02f, 1.333521493e-02f, 9.999999776e-03f, 7.498941850e-03f, 5.623413250e-03f, 4.216964822e-03f, 3.162277630e-03f, 2.371373586e-03f, 1.778279431e-03f, 1.333521446e-03f, 1.000000047e-03f, 7.498942432e-04f, 5.623413017e-04f, 4.216965172e-04f, 3.162277571e-04f, 2.371373703e-04f, 1.778279402e-04f, 1.333521504e-04f};

__device__ __forceinline__ int rope_perm64(int p) { const int g = p >> 3, i = p & 7; return (i < 4) ? 4 * g + i : 32 + 4 * g + (i - 4); }
__device__ __forceinline__ int rope_perm32(int p) { const int g = p >> 3, i = p & 7; return (i < 4) ? 4 * g + i : 16 + 4 * g + (i - 4); }
__device__ __forceinline__ int map_in(int n) {
    if (n < 3072) { const int kind = n >> 9, p = n & 511;
        const int base = (kind == 0) ? 0 : (kind == 1) ? 512 : (kind == 2) ? 1024 : (kind == 3) ? 1832 : (kind == 4) ? 2344 : 2856;
        if (kind == 2 || kind == 5) return base + p;
        return base + (p & ~63) + rope_perm64(p & 63); }
    n -= 3072; if (n < 256) return 1536 + (n & ~31) + rope_perm32(n & 31);
    n -= 256; if (n < 32) return 1792 + rope_perm32(n);
    n -= 32; if (n < 8) return 1824 + n;
    return -1;
}
template <int MODE>
__device__ __forceinline__ void transpose_item(const float* W, const float* W2, int K, int Nsrc, int Nst, const float* gain, bf16* WT, LAS float* scr, int item, int lane) {
    const int nblk = Nst / 32, kb = item / nblk, nb = item % nblk, k0 = 64 * kb, n0 = 32 * nb;
    const int r = lane >> 3, cg = lane & 7, nst = n0 + 4 * cg;
    const float* src = W; int sc = nst;
    if (MODE == 1) sc = map_in(nst);
    if (MODE == 2) { const int pn = nst >> 8, c = nst & 255; src = (c < 128) ? W : W2; sc = pn * 128 + (c & 127); }
    f32x4 tv[8];
    const int scc = sc >= 0 ? sc : 0;
#pragma unroll
    for (int i = 0; i < 8; ++i) tv[i] = __builtin_nontemporal_load((const GAS f32x4*)(src + (size_t)(k0 + r + 8 * i) * Nsrc + scc));
#pragma unroll
    for (int i = 0; i < 8; ++i) { const int kk = r + 8 * i; f32x4 v = tv[i]; if (sc < 0) v = (f32x4){0.f, 0.f, 0.f, 0.f}; if (MODE != 0) v = v * gain[k0 + kk];
        LAS float* d = scr + kk * 33 + 4 * cg; d[0] = v[0]; d[1] = v[1]; d[2] = v[2]; d[3] = v[3]; }
    LDS_WAIT(); asm volatile("" ::: "memory");
    const int c = lane & 7;
#pragma unroll
    for (int j = 0; j < 4; ++j) { const int n = (lane >> 3) + 8 * j; const LAS float* s = scr + (8 * c) * 33 + n;
        v4u o; o.x = pk2(s[0 * 33], s[1 * 33]); o.y = pk2(s[2 * 33], s[3 * 33]); o.z = pk2(s[4 * 33], s[5 * 33]); o.w = pk2(s[6 * 33], s[7 * 33]);
        *(GAS v4u*)(WT + (size_t)(n0 + n) * K + k0 + 8 * c) = o; }
    LDS_WAIT(); asm volatile("" ::: "memory");
}
struct Inputs { const float *x, *w_in, *w_out, *g_mix, *lq1, *lk1, *lq2, *lk2, *g_subln, *g_ffn, *w_gate, *w_up, *w_down, *g_final; };

__device__ __forceinline__ void p0_prologue(Frame& F, const Inputs& I) {
    LAS float* scr = (LAS float*)(F.lds + F.wave * 16384);
    const int gw = F.vcu * NWAVES + F.wave, NGW = F.G * NWAVES;
    constexpr int I_IN = (D / 64) * (DINP / 32), I_OUT = (D / 64) * (D / 32), I_GU = (D / 64) * (NGU / 32), I_DN = (DFF / 64) * (D / 32), I_LAYER = I_IN + I_OUT + I_GU + I_DN;
    for (int it = gw; it < NLAYER * I_LAYER; it += NGW) {
        const int l = it / I_LAYER; int r = it % I_LAYER;
        unsigned char* wl = F.ws + WS_W + (size_t)l * W_LAYER;
        if (r < I_IN) { transpose_item<1>(I.w_in + (size_t)l * D * DIN_SRC, nullptr, D, DIN_SRC, DINP, I.g_mix + l * D, (bf16*)(wl + WO_IN), scr, r, F.lane); continue; } r -= I_IN;
        if (r < I_OUT) { transpose_item<0>(I.w_out + (size_t)l * D * D, nullptr, D, D, D, nullptr, (bf16*)(wl + WO_OUT), scr, r, F.lane); continue; } r -= I_OUT;
        if (r < I_GU) { transpose_item<2>(I.w_gate + (size_t)l * D * DFF, I.w_up + (size_t)l * D * DFF, D, DFF, NGU, I.g_ffn + l * D, (bf16*)(wl + WO_GU), scr, r, F.lane); continue; } r -= I_GU;
        transpose_item<0>(I.w_down + (size_t)l * DFF * D, nullptr, DFF, D, D, nullptr, (bf16*)(wl + WO_DN), scr, r, F.lane);
    }
    { float* cs64 = (float*)(F.ws + WS_CS64); float* cs32 = (float*)(F.ws + WS_CS32);
      const int gt = F.vcu * (NWAVES * 64) + F.tid, NGT = F.G * NWAVES * 64;
      for (int e = gt; e < T * 48; e += NGT) {
          const int t = e / 48, jj = e % 48; const bool is64 = jj < 32; const int j = is64 ? jj : jj - 32;
          const float inv = is64 ? INV64[j] : INV64[2 * j];
          const float ang = (float)t * inv;
          double rev = (double)ang * 0.15915494309189535; rev -= __builtin_floor(rev);
          const float c = __builtin_amdgcn_cosf((float)rev), s = __builtin_amdgcn_sinf((float)rev);
          float* dst = is64 ? cs64 + (size_t)t * 64 + 8 * (j >> 2) + (j & 3) : cs32 + (size_t)t * 32 + 8 * (j >> 2) + (j & 3);
          dst[0] = c; dst[4] = s; } }
    { u64* ssq0 = (u64*)(F.ws + WS_SSQ); bf16* XN = (bf16*)(F.ws + WS_XN);
      for (int m0 = gw; m0 < M; m0 += 4 * NGW) {
          f32x4 v[4][4];
#pragma unroll
          for (int r = 0; r < 4; ++r) { const int mr = (m0 + r * NGW < M) ? m0 + r * NGW : m0; const GAS f32x4* xr = (const GAS f32x4*)(I.x + (size_t)mr * D) + F.lane;
#pragma unroll
              for (int j = 0; j < 4; ++j) v[r][j] = __builtin_nontemporal_load(xr + 64 * j); }
#pragma unroll
          for (int r = 0; r < 4; ++r) { const int m = m0 + r * NGW; if (m >= M) break; float s = 0.f;
#pragma unroll
              for (int j = 0; j < 4; ++j) s += (v[r][j].x * v[r][j].x + v[r][j].y * v[r][j].y) + (v[r][j].z * v[r][j].z + v[r][j].w * v[r][j].w);
              s = wave_sum(s);
              GAS u64* o8 = (GAS u64*)(XN + (size_t)m * D) + F.lane;
#pragma unroll
              for (int j = 0; j < 4; ++j) o8[64 * j] = (u64)pk2(v[r][j].x, v[r][j].y) | ((u64)pk2(v[r][j].z, v[r][j].w) << 32);
              if (F.lane == 0) ssq0[m] = (u64)(s * SSQ_FIX); } } }
}
__device__ __forceinline__ void final_norm(Frame& F0, float* out, const bf16* XN, const u64* ssq, const float* g) {
    Frame F = F0; { int t_ = F0.tid; asm volatile("" : "+v"(t_)); F.tid = t_; F.lane = t_ & 63; F.wave = __builtin_amdgcn_readfirstlane(t_ >> 6); }
    const int gw = F.vcu * NWAVES + F.wave, NGW = F.G * NWAVES;
    f32x4 gv[4];
#pragma unroll
    for (int j = 0; j < 4; ++j) gv[j] = ((const GAS f32x4*)g)[F.lane + 64 * j];
    for (int m0 = gw; m0 < M; m0 += 4 * NGW) {
        u64 w[4][4]; u64 sq[4];
#pragma unroll
        for (int r = 0; r < 4; ++r) { const int mr = (m0 + r * NGW < M) ? m0 + r * NGW : m0; const GAS u64* xb = (const GAS u64*)(XN + (size_t)mr * D) + F.lane; sq[r] = ssq[mr];
#pragma unroll
            for (int j = 0; j < 4; ++j) w[r][j] = __builtin_nontemporal_load(xb + 64 * j); }
#pragma unroll
        for (int r = 0; r < 4; ++r) { const int m = m0 + r * NGW; if (m >= M) break;
            GAS f32x4* xr = (GAS f32x4*)(out + (size_t)m * D) + F.lane;
            const float rs = __builtin_amdgcn_rsqf((float)sq[r] * (SSQ_UNFIX / 1024.0f) + 1e-6f);
#pragma unroll
            for (int j = 0; j < 4; ++j) { const unsigned lo = (unsigned)w[r][j], hi = (unsigned)(w[r][j] >> 32);
                const f32x4 v = {__uint_as_float(lo << 16), __uint_as_float(lo & 0xffff0000u), __uint_as_float(hi << 16), __uint_as_float(hi & 0xffff0000u)};
                __builtin_nontemporal_store(v * rs * gv[j], xr + 64 * j); } } }
}

constexpr int SEL_HIST = 0, SEL_CAND = 65536, SEL_CNT = 98304;
#define SEL_BAR() asm volatile("s_waitcnt lgkmcnt(0)\n\ts_barrier" ::: "memory")
struct SelCtx { bf16x8 afr[2][2]; float wv[2][2][8]; };
__device__ __forceinline__ float sel_relu(float x) { const int b = (int)__float_as_uint(x); return __uint_as_float((unsigned)(b > 0 ? b : 0)); }
__device__ __forceinline__ void sel_load(bf16x8 (&bfr)[2][2], const bf16* ikb, int stride, int r32, int hi) {
#pragma unroll
    for (int ct = 0; ct < 2; ++ct)
#pragma unroll
        for (int kh = 0; kh < 2; ++kh) bfr[ct][kh] = *(const bf16x8*)(ikb + (size_t)((32 * ct + r32) * stride) * 32 + 16 * kh + 8 * hi);
}
__device__ __forceinline__ void sel_scores(const SelCtx& C, const bf16x8 (&bfr)[2][2], float (&sc)[2][2][2]) {
    f32x16 acc[2][2];
#pragma unroll
    for (int at = 0; at < 2; ++at)
#pragma unroll
        for (int ct = 0; ct < 2; ++ct) { const f32x16 z = {}; acc[at][ct] = __builtin_amdgcn_mfma_f32_32x32x16_bf16(C.afr[at][0], bfr[ct][0], z, 0, 0, 0); }
#pragma unroll
    for (int at = 0; at < 2; ++at)
#pragma unroll
        for (int ct = 0; ct < 2; ++ct) acc[at][ct] = __builtin_amdgcn_mfma_f32_32x32x16_bf16(C.afr[at][1], bfr[ct][1], acc[at][ct], 0, 0, 0);
    __builtin_amdgcn_sched_barrier(0);
#pragma unroll
    for (int at = 0; at < 2; ++at)
#pragma unroll
        for (int ct = 0; ct < 2; ++ct)
#pragma unroll
            for (int r = 0; r < 16; ++r) acc[at][ct][r] = sel_relu(acc[at][ct][r]);
    __builtin_amdgcn_sched_barrier(0);
#pragma unroll
    for (int at = 0; at < 2; ++at)
#pragma unroll
        for (int ct = 0; ct < 2; ++ct) { sc[at][ct][0] = C.wv[at][0][0] * acc[at][ct][0]; sc[at][ct][1] = C.wv[at][1][0] * acc[at][ct][8]; }
#pragma unroll
    for (int r = 1; r < 8; ++r)
#pragma unroll
        for (int at = 0; at < 2; ++at)
#pragma unroll
            for (int ct = 0; ct < 2; ++ct) { sc[at][ct][0] = __builtin_fmaf(C.wv[at][0][r], acc[at][ct][r], sc[at][ct][0]); sc[at][ct][1] = __builtin_fmaf(C.wv[at][1][r], acc[at][ct][8 + r], sc[at][ct][1]); }
    __builtin_amdgcn_sched_barrier(0);
}
__device__ __forceinline__ unsigned sel_q16(float s, float c0, float inv) { return (unsigned)__builtin_amdgcn_fmed3f(__builtin_fmaf(s, inv, c0), 0.f, 65535.f); }

__device__ __forceinline__ void select_unit(Frame& F, int b, int c, const bf16* IQ, const bf16* IK, const float* IW, u64* MASK, v4u* SB) {
    const int lane = F.lane, w = F.wave, r32 = lane & 31, hi = lane >> 5, tid = F.tid;
    const size_t brow = (size_t)b * T; const int q0 = 64 * c;
    GAS u64* mrow = (GAS u64*)MASK + (size_t)b * 128 * T;
    GAS v4u* sbw = (GAS v4u*)SB + F.wave * 64 + F.lane;
    if (c < 4) {
        if (tid < 256) { const int tile = tid >> 6; mrow[(size_t)tile * T + q0 + (tid & 63)] = (tile <= c) ? ~0ull : 0ull; }
        return;
    }
    LAS unsigned* HIST = (LAS unsigned*)(F.lds + SEL_HIST);
    LAS u64* CAND = (LAS u64*)(F.lds + SEL_CAND);
    LAS int* CCNT = (LAS int*)(F.lds + SEL_CNT); LAS int* QBIN = CCNT + 64; LAS int* NEED = CCNT + 128;
    SelCtx C;
    { const int q4 = 2 * (r32 >> 4) + ((r32 >> 2) & 1), head = 4 * ((r32 >> 3) & 1) + (r32 & 3);
#pragma unroll
      for (int at = 0; at < 2; ++at)
#pragma unroll
          for (int kh = 0; kh < 2; ++kh) C.afr[at][kh] = *(const bf16x8*)(IQ + (brow + q0 + 8 * w + 4 * at + q4) * 256 + head * 32 + 16 * kh + 8 * hi);
#pragma unroll
      for (int at = 0; at < 2; ++at)
#pragma unroll
          for (int ab = 0; ab < 2; ++ab) { const float* wp = IW + (brow + q0 + 8 * w + 4 * at + 2 * ab + hi) * 8; const f32x4 a = *(const f32x4*)wp, bb = *(const f32x4*)(wp + 4);
#pragma unroll
              for (int i = 0; i < 4; ++i) { C.wv[at][ab][i] = a[i]; C.wv[at][ab][4 + i] = bb[i]; } } }
    const bf16* ik0 = IK + brow * 32;
    bf16x8 bA[2][2], bB[2][2];
    sel_load(bA, ik0, 1, r32, hi); sel_load(bB, ik0 + (size_t)64 * 32, 1, r32, hi);
    float lo[2][2], inv[2][2];
    { float sc[2][2][2]; bf16x8 bs[2][2]; sel_load(bs, ik0, c + 1, r32, hi); sel_scores(C, bs, sc);
#pragma unroll
      for (int at = 0; at < 2; ++at)
#pragma unroll
          for (int ab = 0; ab < 2; ++ab) { float s1 = sc[at][0][ab] + sc[at][1][ab], s2 = sc[at][0][ab] * sc[at][0][ab] + sc[at][1][ab] * sc[at][1][ab];
#pragma unroll
              for (int o = 1; o < 32; o <<= 1) { s1 += __shfl_xor(s1, o); s2 += __shfl_xor(s2, o); }
              const float mean = s1 * (1.f / 64.f), var = __builtin_fmaxf(s2 * (1.f / 64.f) - mean * mean, 0.f), sd = __builtin_sqrtf(var);
              inv[at][ab] = (sd > 1e-30f) ? 8192.0f / sd : 0.f; lo[at][ab] = -(mean - 2.5f * sd) * inv[at][ab]; } }
    { LAS v4u* hz = (LAS v4u*)HIST;
#pragma unroll
      for (int i = 0; i < 8; ++i) hz[tid + 512 * i] = (v4u){0u, 0u, 0u, 0u}; }
    SEL_BAR();
#define SEL_P1(BF, KB) do { float sc[2][2][2]; sel_scores(C, BF, sc); v4u rec; \
        _Pragma("unroll") for (int at = 0; at < 2; ++at) _Pragma("unroll") for (int ct = 0; ct < 2; ++ct) { unsigned q2[2]; \
            _Pragma("unroll") for (int ab = 0; ab < 2; ++ab) { q2[ab] = sel_q16(sc[at][ct][ab], lo[at][ab], inv[at][ab]); \
                __hip_atomic_fetch_add(HIST + (8 * w + 4 * at + 2 * ab + hi) * 256 + (q2[ab] >> 8), 1u, __ATOMIC_RELAXED, __HIP_MEMORY_SCOPE_WORKGROUP); } \
            rec[2 * at + ct] = q2[0] | (q2[1] << 16); } \
        __builtin_nontemporal_store(rec, sbw + (size_t)(KB) * 512); } while (0)
    for (int kb = 0; kb <= c; kb += 2) {
        SEL_P1(bA, kb); __builtin_amdgcn_sched_barrier(0); sel_load(bA, ik0 + (size_t)(kb + 2 <= c ? kb + 2 : c) * 64 * 32, 1, r32, hi);
        __builtin_amdgcn_sched_barrier(0);
        if (kb + 1 <= c) { SEL_P1(bB, kb + 1); __builtin_amdgcn_sched_barrier(0); } sel_load(bB, ik0 + (size_t)(kb + 3 <= c ? kb + 3 : c) * 64 * 32, 1, r32, hi);
    }
#undef SEL_P1
    SEL_BAR();
    for (int qi = 0; qi < 8; ++qi) {
        const int q = 8 * w + qi; const v4u hv = *(LAS v4u*)(HIST + q * 256 + 4 * lane);
        const int tot = (int)(hv[0] + hv[1] + hv[2] + hv[3]);
        int suf = tot;
#pragma unroll
        for (int o = 1; o < 64; o <<= 1) { const int tv = __shfl_down(suf, o); if (lane + o < 64) suf += tv; }
        const int above = suf - tot;
        if (suf >= 256 && above < 256) {
            int cum = above, bsel = 0, need = 1; bool found = false;
#pragma unroll
            for (int k = 3; k >= 0; --k) { if (!found) { if (cum + (int)hv[k] >= 256) { found = true; bsel = 4 * lane + k; need = 256 - cum; } else cum += (int)hv[k]; } }
            QBIN[q] = bsel; NEED[q] = need; CCNT[q] = 0;
        }
    }
    SEL_BAR();
    int qbn[2][2];
#pragma unroll
    for (int at = 0; at < 2; ++at)
#pragma unroll
        for (int ab = 0; ab < 2; ++ab) qbn[at][ab] = QBIN[8 * w + 4 * at + 2 * ab + hi];
    LAS unsigned* MST = HIST;
#define SEL_P2(RC, KB) do { unsigned q8[2][2][2]; u64 bal[2][2][2]; \
        _Pragma("unroll") for (int at = 0; at < 2; ++at) _Pragma("unroll") for (int ct = 0; ct < 2; ++ct) _Pragma("unroll") for (int ab = 0; ab < 2; ++ab) { \
            q8[at][ct][ab] = ab ? (RC[2 * at + ct] >> 16) : (RC[2 * at + ct] & 0xffffu); bal[at][ct][ab] = __ballot(q8[at][ct][ab] >= tab_[at][ab]); } \
        if (lane == 0) { _Pragma("unroll") for (int at = 0; at < 2; ++at) _Pragma("unroll") for (int ct = 0; ct < 2; ++ct) _Pragma("unroll") for (int ab = 0; ab < 2; ++ab) \
            *(LAS u64*)(MST + ((KB) * 2 + ct) * 64 + 8 * w + 4 * at + 2 * ab) = bal[at][ct][ab]; } \
        _Pragma("unroll") for (int at = 0; at < 2; ++at) _Pragma("unroll") for (int ct = 0; ct < 2; ++ct) _Pragma("unroll") for (int ab = 0; ab < 2; ++ab) { \
            const bool isc_ = (q8[at][ct][ab] >> 8) == (unsigned)qbn[at][ab]; const u64 cb_ = __ballot(isc_); \
            if (__builtin_expect(cb_ != 0ull, 0)) { const int nlo_ = __builtin_popcount((unsigned)cb_), nhi_ = __builtin_popcount((unsigned)(cb_ >> 32)); \
                const int below_ = (int)__builtin_amdgcn_mbcnt_hi((unsigned)(cb_ >> 32), __builtin_amdgcn_mbcnt_lo((unsigned)cb_, 0u)); \
                const int pos = ccv[at][ab] + (hi ? below_ - nlo_ : below_); \
                if (isc_ && pos < 64) CAND[(8 * w + 4 * at + 2 * ab + hi) * 64 + pos] = ((u64)q8[at][ct][ab] << 32) | (unsigned)((KB) * 64 + 32 * ct + r32); \
                ccv[at][ab] += hi ? nhi_ : nlo_; } } } while (0)
    int ccv[2][2] = {{0, 0}, {0, 0}};
    unsigned tab_[2][2];
#pragma unroll
    for (int at = 0; at < 2; ++at)
#pragma unroll
        for (int ab = 0; ab < 2; ++ab) tab_[at][ab] = (unsigned)(qbn[at][ab] + 1) << 8;
    { v4u ra[8], rb[8];
#pragma unroll
      for (int i = 0; i < 8; ++i) ra[i] = __builtin_nontemporal_load(sbw + (size_t)(i <= c ? i : c) * 512);
      for (int kb = 0; kb <= c; kb += 16) {
#pragma unroll
          for (int i = 0; i < 8; ++i) rb[i] = __builtin_nontemporal_load(sbw + (size_t)(kb + 8 + i <= c ? kb + 8 + i : c) * 512);
#pragma unroll
          for (int i = 0; i < 8; ++i) { if (kb + i <= c) SEL_P2(ra[i], kb + i); }
#pragma unroll
          for (int i = 0; i < 8; ++i) ra[i] = __builtin_nontemporal_load(sbw + (size_t)(kb + 16 + i <= c ? kb + 16 + i : c) * 512);
#pragma unroll
          for (int i = 0; i < 8; ++i) { if (kb + 8 + i <= c) SEL_P2(rb[i], kb + 8 + i); } } }
#undef SEL_P2
    if (r32 == 0) {
#pragma unroll
        for (int at = 0; at < 2; ++at)
#pragma unroll
            for (int ab = 0; ab < 2; ++ab) CCNT[8 * w + 4 * at + 2 * ab + hi] = ccv[at][ab]; }
    SEL_BAR();
    for (int qi = 0; qi < 8; ++qi) {
        const int q = 8 * w + qi; int n = __builtin_amdgcn_readfirstlane(CCNT[q]); n = n < 64 ? n : 64; const int need = __builtin_amdgcn_readfirstlane(NEED[q]);
        const u64 my = (lane < n) ? CAND[q * 64 + lane] : 0ull; const unsigned myv = (unsigned)(my >> 32); const unsigned myk = (unsigned)my;
        int rank = 0;
        for (int j = 0; j < n; ++j) { const unsigned vj = (unsigned)__builtin_amdgcn_readlane((int)(unsigned)(my >> 32), j); const unsigned kj = (unsigned)__builtin_amdgcn_readlane((int)myk, j); rank += (vj > myv || (vj == myv && kj < myk)) ? 1 : 0; }
        if (lane < n && rank < need) __hip_atomic_fetch_or(MST + ((myk >> 6) * 2 + ((myk >> 5) & 1)) * 64 + q, 1u << (myk & 31), __ATOMIC_RELAXED, __HIP_MEMORY_SCOPE_WORKGROUP);
    }
    SEL_BAR();
    { for (int tile = tid >> 6; tile <= c; tile += 8) mrow[(size_t)tile * T + q0 + (tid & 63)] = (u64)MST[(tile * 2) * 64 + (tid & 63)] | ((u64)MST[(tile * 2 + 1) * 64 + (tid & 63)] << 32);
      const int nz = ((c | 3) - c) * 64;
      for (int i = tid; i < nz; i += 512) mrow[(size_t)(c + 1 + (i >> 6)) * T + q0 + (i & 63)] = 0ull; }
    SEL_BAR();
}
namespace att { __device__ __forceinline__ int crow(int r, int hi); }
template <int NJ>
__device__ __forceinline__ void vt8_jobs(Frame& F, int job0) {
    const int slab = F.wave & 1, cc = F.wave >> 1, h = cc >> 1, kb = 32 * (cc & 1), col = slab * 256 + 4 * F.lane;
    unsigned d[NJ][16];
#pragma unroll
    for (int jj = 0; jj < NJ; ++jj) { const int job = job0 + jj, mixer = job >> 9, b = (job >> 7) & 3, tile = job & 127;
        const unsigned char* V = F.ws + WS_QKV + (mixer ? pg8::QKV_VB : pg8::QKV_VA) + ((size_t)b * T + tile * 64) * 512 + col;
#pragma unroll
        for (int j = 0; j < 16; ++j) d[jj][j] = __builtin_nontemporal_load((const unsigned*)(V + (size_t)(kb + att::crow(j, h)) * 512)); }
#pragma unroll
    for (int jj = 0; jj < NJ; ++jj) { const int job = job0 + jj, mixer = job >> 9, b = (job >> 7) & 3, tile = job & 127;
        unsigned char* VT = F.ws + WS_QKV + (mixer ? pg8::QKV_VT8B + ((((size_t)(b * 4 + (col >> 7)) * 128 + tile) * 4 + cc) * 128 + (col & 127)) * 16
                                                   : pg8::QKV_VT8A + ((((size_t)(b * 8 + (col >> 6)) * 128 + tile) * 4 + cc) * 64 + (col & 63)) * 16);
        v4u o[4];
#pragma unroll
        for (int q = 0; q < 4; ++q) { const unsigned t0 = __builtin_amdgcn_perm(d[jj][4 * q + 1], d[jj][4 * q], 0x05010400u), t1 = __builtin_amdgcn_perm(d[jj][4 * q + 1], d[jj][4 * q], 0x07030602u);
            const unsigned u0 = __builtin_amdgcn_perm(d[jj][4 * q + 3], d[jj][4 * q + 2], 0x05010400u), u1 = __builtin_amdgcn_perm(d[jj][4 * q + 3], d[jj][4 * q + 2], 0x07030602u);
            o[0][q] = __builtin_amdgcn_perm(u0, t0, 0x05040100u); o[1][q] = __builtin_amdgcn_perm(u0, t0, 0x07060302u);
            o[2][q] = __builtin_amdgcn_perm(u1, t1, 0x05040100u); o[3][q] = __builtin_amdgcn_perm(u1, t1, 0x07060302u); }
#pragma unroll
        for (int c = 0; c < 4; ++c) *(v4u*)(VT + c * 16) = o[c]; }
}
__device__ __forceinline__ void select_phase(Frame& F0, float* out) {
    Frame F = F0; { int t_ = F0.tid; asm volatile("" : "+v"(t_)); F.tid = t_; F.lane = t_ & 63; F.wave = __builtin_amdgcn_readfirstlane(t_ >> 6); }
    const bf16* IQ = (const bf16*)(F.ws + WS_IQ); const bf16* IK = (const bf16*)(F.ws + WS_IK); const float* IW = (const float*)(F.ws + WS_IW); u64* MASK = (u64*)(F.ws + WS_MASK);
    for (int v = F.vcu; v < 256; v += F.G) {
        const int b = v >> 6, s = v & 63;
        const size_t pre = (size_t)(128 * s - (s * (s - 1)) / 2);
        unsigned char* sbp = (b == 0) ? (unsigned char*)out + pre * 8192 : (b == 1) ? (unsigned char*)out + (6176 + pre) * 8192 : (b == 2) ? F.ws + WS_MIX + pre * 8192
                           : (s < 32) ? (unsigned char*)out + (2 * 6176 + pre) * 8192 : F.ws + WS_O0 + (pre - 3600) * 8192;
        v4u* SB = (v4u*)sbp;
#pragma unroll 1
        for (int i = 0; i < 2; ++i) { select_unit(F, b, i == 0 ? s : 127 - s, IQ, IK, IW, MASK, SB);
            if (i == 0) {
#pragma unroll 1
                for (int j = 0; j < 4; j += 2) vt8_jobs<2>(F, 4 * v + j); } }
    }
}

namespace att {
constexpr int LDS_K = 0, LDS_V = 32768, LDS_Q = 65536, LDS_MK = 98304, LDS_WS = 106496, LDS_ONES = 108544, LDS_OST = 0;
__device__ __forceinline__ int crow(int r, int hi) { return (r & 3) + 8 * (r >> 2) + 4 * hi; }
template <int OFF> __device__ __forceinline__ void glds16o(const void* gsrc, unsigned lds_base) { unsigned keep;
    asm volatile("s_mov_b32 %0, m0\n\ts_add_u32 m0, %2, %3\n\ts_nop 0\n\tglobal_load_lds_dwordx4 %1, off\n\ts_mov_b32 m0, %0" : "=&s"(keep) : "v"(gsrc), "s"(lds_base), "n"(OFF) : "memory", "scc"); }
template <int OFF> __device__ __forceinline__ void glds4o(const void* gsrc, unsigned lds_base) { unsigned keep;
    asm volatile("s_mov_b32 %0, m0\n\ts_add_u32 m0, %2, %3\n\ts_nop 0\n\tglobal_load_lds_dword %1, off\n\ts_mov_b32 m0, %0" : "=&s"(keep) : "v"(gsrc), "s"(lds_base), "n"(OFF) : "memory", "scc"); }
template <int OFF> __device__ __forceinline__ void glds16s(unsigned voff, const void* sbase, unsigned lds_base) { unsigned keep;
    asm volatile("s_mov_b32 %0, m0\n\ts_add_u32 m0, %3, %4\n\ts_nop 0\n\tglobal_load_lds_dwordx4 %1, %2\n\ts_mov_b32 m0, %0" : "=&s"(keep) : "v"(voff), "s"(sbase), "s"(lds_base), "n"(OFF) : "memory", "scc"); }
template <int OFF> __device__ __forceinline__ void glds4s(unsigned voff, const void* sbase, unsigned lds_base) { unsigned keep;
    asm volatile("s_mov_b32 %0, m0\n\ts_add_u32 m0, %3, %4\n\ts_nop 0\n\tglobal_load_lds_dword %1, %2\n\ts_mov_b32 m0, %0" : "=&s"(keep) : "v"(voff), "s"(sbase), "s"(lds_base), "n"(OFF) : "memory", "scc"); }
__device__ __forceinline__ float max3f(float a, float b, float c) { return __builtin_fmaxf(__builtin_fmaxf(a, b), c); }
typedef float f32x2_t __attribute__((ext_vector_type(2))); typedef __bf16 bf16x2_t __attribute__((ext_vector_type(2)));
__device__ __forceinline__ unsigned cvtpk_s(float lo, float hi) { f32x2_t v = {lo, hi}; bf16x2_t b = __builtin_convertvector(v, bf16x2_t); return __builtin_bit_cast(unsigned, b); }
#define ATT_WAIT_BAR() asm volatile("s_waitcnt vmcnt(0) lgkmcnt(0)\n\ts_barrier" ::: "memory")
__device__ __forceinline__ float rowmax(const f32x16& p0, const f32x16& p1) {
    float a = max3f(p0[0], p0[1], p1[0]), b = max3f(p0[2], p0[3], p1[1]); a = max3f(a, p1[2], p1[3]);
#pragma unroll
    for (int r = 4; r < 16; r += 4) { a = max3f(a, p0[r], p0[r + 1]); b = max3f(b, p0[r + 2], p0[r + 3]); a = max3f(a, p1[r], p1[r + 1]); b = max3f(b, p1[r + 2], p1[r + 3]); }
    const float m = __builtin_fmaxf(a, b);
    auto rr = __builtin_amdgcn_permlane32_swap(__float_as_uint(m), __float_as_uint(m), false, false);
    float m2; asm("v_max_f32 %0, %1, %2" : "=v"(m2) : "v"(rr[0]), "v"(rr[1]));
    return m2;
}
typedef int v8i __attribute__((ext_vector_type(8)));
constexpr float ATT_THR = 8.0f, ATT_C0 = 4.0f;
constexpr int SC_ONE = 0x7F7F7F7F, SC_8TH = 0x7C7C7C7C;
__device__ __forceinline__ void qkt8(f32x16& p0, f32x16& p1, const LAS char* Kslot, const v8i& q8, const f32x16& c, int r32, int hi) {
    const LAS char* kb = Kslot + hi * 2048 + r32 * 16;
    const v4u a00 = *(const LAS v4u*)(kb), a01 = *(const LAS v4u*)(kb + 1024), a10 = *(const LAS v4u*)(kb + 512), a11 = *(const LAS v4u*)(kb + 1024 + 512);
    __builtin_amdgcn_sched_barrier(0);
    const v8i A0 = {(int)a00[0], (int)a00[1], (int)a00[2], (int)a00[3], (int)a01[0], (int)a01[1], (int)a01[2], (int)a01[3]};
    const v8i A1 = {(int)a10[0], (int)a10[1], (int)a10[2], (int)a10[3], (int)a11[0], (int)a11[1], (int)a11[2], (int)a11[3]};
    p0 = __builtin_amdgcn_mfma_scale_f32_32x32x64_f8f6f4(A0, q8, c, 0, 0, 0, SC_ONE, 0, SC_8TH);
    p1 = __builtin_amdgcn_mfma_scale_f32_32x32x64_f8f6f4(A1, q8, c, 0, 0, 0, SC_ONE, 0, SC_8TH);
}
template <int ND>
__device__ __forceinline__ void pv8(f32x16* o, f32x16& osum, const LAS char* Vslot, const LAS char* onesp, const v8i& pa, int r32, int hi) {
    const v4u on0 = *(const LAS v4u*)onesp, on1 = *(const LAS v4u*)(onesp + 16);
    v4u b0[ND], b1[ND];
#pragma unroll
    for (int d = 0; d < ND; ++d) { const LAS char* vb = Vslot + (2 * hi) * (ND * 32 * 16) + (32 * d + r32) * 16; b0[d] = *(const LAS v4u*)vb; b1[d] = *(const LAS v4u*)(vb + ND * 32 * 16); }
    __builtin_amdgcn_sched_barrier(0);
#pragma unroll
    for (int d = 0; d < ND; ++d) { const v8i B = {(int)b0[d][0], (int)b0[d][1], (int)b0[d][2], (int)b0[d][3], (int)b1[d][0], (int)b1[d][1], (int)b1[d][2], (int)b1[d][3]};
        o[d] = __builtin_amdgcn_mfma_scale_f32_32x32x64_f8f6f4(pa, B, o[d], 0, 0, 0, SC_ONE, 0, SC_ONE); }
    const v8i ones = {(int)on0[0], (int)on0[1], (int)on0[2], (int)on0[3], (int)on1[0], (int)on1[1], (int)on1[2], (int)on1[3]};
    osum = __builtin_amdgcn_mfma_scale_f32_32x32x64_f8f6f4(pa, ones, osum, 0, 0, 0, SC_ONE, 0, SC_ONE);
}
template <bool QLDS>
__device__ __forceinline__ void qkt_c(f32x16& p0, f32x16& p1, const LAS char* Kslot, const bf16x8* qr, const LAS char* qst, const f32x16& c, int r32, int hi) {
    const LAS char* kb = Kslot + hi * 1024 + r32 * 16;
    bf16x8 kf[8], q[4];
#pragma unroll
    for (int d0 = 0; d0 < 4; ++d0) { kf[2 * d0] = *(const LAS bf16x8*)(kb + d0 * 2048); kf[2 * d0 + 1] = *(const LAS bf16x8*)(kb + d0 * 2048 + 512);
        q[d0] = QLDS ? *(const LAS bf16x8*)(qst + d0 * 1024) : qr[d0]; }
    __builtin_amdgcn_sched_barrier(0);
#pragma unroll
    for (int d0 = 0; d0 < 4; ++d0) {
        if (d0 == 0) { p0 = __builtin_amdgcn_mfma_f32_32x32x16_bf16(kf[0], q[0], c, 0, 0, 0); p1 = __builtin_amdgcn_mfma_f32_32x32x16_bf16(kf[1], q[0], c, 0, 0, 0); }
        else { p0 = __builtin_amdgcn_mfma_f32_32x32x16_bf16(kf[2 * d0], q[d0], p0, 0, 0, 0); p1 = __builtin_amdgcn_mfma_f32_32x32x16_bf16(kf[2 * d0 + 1], q[d0], p1, 0, 0, 0); } }
}
typedef short v4i16_t __attribute__((ext_vector_type(4)));
__device__ __forceinline__ s16x4 vtr(const LAS char* p) { return __builtin_bit_cast(s16x4, __builtin_amdgcn_ds_read_tr16_b64_v4i16((LAS v4i16_t*)p)); }
template <int ND>
__device__ __forceinline__ void pv2(f32x16* o, f32x16& osum, const LAS char* vp, const v4u (&pw)[4]) {
    const bf16x8 ones = {(short)0x3F80, (short)0x3F80, (short)0x3F80, (short)0x3F80, (short)0x3F80, (short)0x3F80, (short)0x3F80, (short)0x3F80};
    s16x4 lo[2][4], hi[2][4];
#define ATT_VRD(d, b) do { const LAS char* vd_ = vp + ((d) >> 1) * 8192 + ((d) & 1) * 4096; \
        _Pragma("unroll") for (int ks = 0; ks < 4; ++ks) { lo[b][ks] = vtr(vd_ + ks * 1024); hi[b][ks] = vtr(vd_ + ks * 1024 + 512); } } while (0)
    ATT_VRD(0, 0);
    __builtin_amdgcn_sched_barrier(0);
#pragma unroll
    for (int d = 0; d < ND; ++d) {
        if (d + 1 < ND) ATT_VRD(d + 1, (d + 1) & 1);
        __builtin_amdgcn_sched_barrier(0);
#pragma unroll
        for (int ks = 0; ks < 4; ++ks) { const s16x4 l_ = lo[d & 1][ks], h_ = hi[d & 1][ks];
            const bf16x8 vf = {l_[0], l_[1], l_[2], l_[3], h_[0], h_[1], h_[2], h_[3]};
            o[d] = __builtin_amdgcn_mfma_f32_32x32x16_bf16(__builtin_bit_cast(bf16x8, pw[ks]), vf, o[d], 0, 0, 0); }
        __builtin_amdgcn_sched_barrier(0);
    }
#undef ATT_VRD
#pragma unroll
    for (int ks = 0; ks < 4; ++ks) osum = __builtin_amdgcn_mfma_f32_32x32x16_bf16(__builtin_bit_cast(bf16x8, pw[ks]), ones, osum, 0, 0, 0);
}
template <int ND>
__device__ __forceinline__ void soft_ref(f32x16& S0, f32x16& S1, f32x16& negm, float& mref, f32x16* o, f32x16& osum, LAS float* wsf, int r32, int hi, bool first) {
    const float rm = rowmax(S0, S1);
    if (__builtin_expect(first || __any(rm > ATT_THR), 0)) {
        const float dl = first ? rm - ATT_C0 : __builtin_fmaxf(rm - ATT_C0, 0.f); mref += dl;
#pragma unroll
        for (int r = 0; r < 16; ++r) { S0[r] -= dl; S1[r] -= dl; negm[r] = -mref; }
        const float f = __builtin_amdgcn_exp2f(-dl);
        if (hi == 0) wsf[r32] = f;
        LDS_WAIT();
#pragma unroll
        for (int r = 0; r < 16; ++r) { const float fr = wsf[crow(r, hi)]; osum[r] *= fr;
#pragma unroll
            for (int d = 0; d < ND; ++d) o[d][r] *= fr; }
    }
}
template <bool MASKED, bool FP>
__device__ __forceinline__ void soft_exp(f32x16& S0, f32x16& S1, u64 mw, v8i& pa, v4u (&pw)[4], int hi) {
#pragma unroll
    for (int r = 0; r < 16; ++r) { S0[r] = __builtin_amdgcn_exp2f(S0[r]); S1[r] = __builtin_amdgcn_exp2f(S1[r]); }
    if (MASKED && !FP) { const int x0 = (int)((unsigned)mw >> (4 * hi)), x1 = (int)((unsigned)(mw >> 32) >> (4 * hi));
#pragma unroll
        for (int r = 0; r < 16; ++r) { int m0_, m1_;
            asm("v_bfe_i32 %0, %1, %2, 1" : "=v"(m0_) : "v"(x0), "n"((r & 3) + 8 * (r >> 2)));
            asm("v_bfe_i32 %0, %1, %2, 1" : "=v"(m1_) : "v"(x1), "n"((r & 3) + 8 * (r >> 2)));
            S0[r] = __uint_as_float(__float_as_uint(S0[r]) & (unsigned)m0_); S1[r] = __uint_as_float(__float_as_uint(S1[r]) & (unsigned)m1_); } }
    if (FP) {
        unsigned cm1 = 0x01010101u, cm2 = 0x0C0C0C0Cu; if (MASKED) { asm volatile("" : "+v"(cm1)); asm volatile("" : "+s"(cm2)); }
#pragma unroll
        for (int d = 0; d < 4; ++d) { int w0 = (int)__float_as_uint(S0[4 * d]), w1 = (int)__float_as_uint(S1[4 * d]);
            w0 = __builtin_amdgcn_cvt_pk_fp8_f32(S0[4 * d], S0[4 * d + 1], w0, false); w0 = __builtin_amdgcn_cvt_pk_fp8_f32(S0[4 * d + 2], S0[4 * d + 3], w0, true);
            w1 = __builtin_amdgcn_cvt_pk_fp8_f32(S1[4 * d], S1[4 * d + 1], w1, false); w1 = __builtin_amdgcn_cvt_pk_fp8_f32(S1[4 * d + 2], S1[4 * d + 3], w1, true);
            if (MASKED) {
                const unsigned n0 = ((unsigned)mw >> (8 * d + 4 * hi)) & 15u, n1 = ((unsigned)(mw >> 32) >> (8 * d + 4 * hi)) & 15u;
                const unsigned s0 = (__umul24(n0, 0x204081u) & cm1) | cm2, s1 = (__umul24(n1, 0x204081u) & cm1) | cm2;
                w0 &= (int)__builtin_amdgcn_perm(0u, 0u, s0); w1 &= (int)__builtin_amdgcn_perm(0u, 0u, s1); }
            pa[d] = w0; pa[4 + d] = w1; }
    } else {
        pw[0] = (v4u){cvtpk_s(S0[0], S0[1]), cvtpk_s(S0[2], S0[3]), cvtpk_s(S0[4], S0[5]), cvtpk_s(S0[6], S0[7])};
        pw[1] = (v4u){cvtpk_s(S0[8], S0[9]), cvtpk_s(S0[10], S0[11]), cvtpk_s(S0[12], S0[13]), cvtpk_s(S0[14], S0[15])};
        pw[2] = (v4u){cvtpk_s(S1[0], S1[1]), cvtpk_s(S1[2], S1[3]), cvtpk_s(S1[4], S1[5]), cvtpk_s(S1[6], S1[7])};
        pw[3] = (v4u){cvtpk_s(S1[8], S1[9]), cvtpk_s(S1[10], S1[11]), cvtpk_s(S1[12], S1[13]), cvtpk_s(S1[14], S1[15])};
    }
}
template <int DV, bool MASKED, int OUT, bool FQ, bool FP, bool STAG = false>
__device__ __forceinline__ void attn_unit(LAS char* shm, int wid, int lane, const void* Qp_, const void* Kp_, const void* Vp_, int qb, const GAS u64* maskp, bf16* Od, float* O0s, float lam, float osc, const float* gsub) {
    constexpr int ND = DV / 32, NSUB = DV / 64, KSL = FQ ? 4096 : 8192, VSL = FP ? DV * 64 : NSUB * 8192;
    constexpr int IPS = (FQ && FP) ? 2 : ((FQ ? 1 : 1) + (FP ? 1 : NSUB) + (MASKED ? 1 : 0));
    static_assert(!(FQ && !FP) && !(FP && DV == 64 && !FQ), "supported: all bf16; all fp8; bf16 QK^T with fp8 P.V at DV 128");
    const int r32 = lane & 31, hi = lane >> 5;
    const unsigned lds0 = (unsigned)(size_t)shm;
    LAS float* wsf = (LAS float*)(shm + LDS_WS) + wid * 64;
    const LAS char* mring = shm + LDS_MK + wid * 1024;
    const int NT = 4 * qb + 4, cq = 4 * qb + (wid >> 1);
    const unsigned wbase = (unsigned)__builtin_amdgcn_readfirstlane(lds0 + wid * 1024);
    constexpr int KTB = FQ ? 4096 : 8192, VTB = DV * 64;
    const unsigned kvo = (unsigned)lane * 16u;
    const unsigned char* ksb = (const unsigned char*)Kp_ + (FQ ? (wid & 3) : wid) * 1024;
    const unsigned kbase = FQ ? (unsigned)__builtin_amdgcn_readfirstlane(lds0 + (wid & 3) * 1024) : wbase;
    const unsigned vvo = FP ? (unsigned)lane * 16u : (unsigned)((lane >> 2) * 1024 + (lane & 3) * 16);
    const unsigned char* vsb = FP ? (const unsigned char*)Vp_ + (DV == 64 ? (wid & 3) * 1024 : (wid & 3) * 2048 + (wid >> 2) * 1024)
                                  : (const unsigned char*)Vp_ + (size_t)(16 * (wid & 3)) * 1024 + (wid >> 2) * 64;
    const unsigned vbase = FP ? (unsigned)__builtin_amdgcn_readfirstlane(lds0 + (DV == 64 ? (wid & 3) * 1024 : (wid & 3) * 2048 + (wid >> 2) * 1024)) : wbase;
    const LAS char* vp0 = shm + LDS_V + ((lane >> 4) & 1) * 32 + (lane & 3) * 8 + (4 * hi + ((lane & 15) >> 2)) * 64;
    const unsigned mvo = (unsigned)lane * 4u;
    const unsigned char* msb = MASKED ? (const unsigned char*)(maskp + qb * 256 + wid * 32) : nullptr;
#define ATT_DMA(t, slot) do { \
        if (FQ) { if (wid < 4) glds16s<LDS_K + (slot) * KSL>(kvo, ksb + (size_t)(t) * KTB, kbase); } \
        else glds16s<LDS_K + (slot) * KSL>(kvo, ksb + (size_t)(t) * KTB, kbase); \
        if (FP) { if (DV == 128 || wid >= 4) glds16s<LDS_V + (slot) * VSL>(vvo, vsb + (size_t)(t) * VTB, vbase); \
                  if (FQ && DV == 128 && wid >= 4) glds16s<LDS_V + (slot) * VSL>(vvo, vsb + (size_t)(t) * VTB, vbase); }     \
        else { glds16s<LDS_V + (slot) * VSL>(vvo, vsb + (size_t)(t) * 64 * 1024, vbase); if (NSUB == 2) glds16s<LDS_V + (slot) * VSL + 8192>(vvo, vsb + (size_t)(t) * 64 * 1024 + 128, vbase); } \
        if (MASKED) glds4s<LDS_MK + (slot) * 256>(mvo, msb + (size_t)(t) * (8 * T), wbase); } while (0)
#define ATT_WAITN(n) do { if ((n) == 2) asm volatile("s_waitcnt vmcnt(2) lgkmcnt(0)\n\ts_barrier" ::: "memory"); else if ((n) == 3) asm volatile("s_waitcnt vmcnt(3) lgkmcnt(0)\n\ts_barrier" ::: "memory"); \
        else asm volatile("s_waitcnt vmcnt(0) lgkmcnt(0)\n\ts_barrier" ::: "memory"); } while (0)
    static_assert(IPS == 2 || IPS == 3, "counted waits exist for 2 and 3 DMA instructions per tile");
    if (FP && wid == 0 && lane < 8) ((LAS unsigned*)(shm + LDS_ONES))[lane] = 0x38383838u;
    unsigned onesa = lds0 + LDS_ONES; asm volatile("" : "+v"(onesa));
    bf16x8 qr[4] = {}; v8i q8 = {};
    if (FQ) { const unsigned char* Qw = (const unsigned char*)Qp_ + (size_t)(qb * 256 + wid * 32) * 512; v4u qa, qb_;
        asm volatile("global_load_dwordx4 %0, %1, off" : "=v"(qa) : "v"(Qw + (size_t)r32 * 512 + hi * 32) : "memory"); asm volatile("global_load_dwordx4 %0, %1, off" : "=v"(qb_) : "v"(Qw + (size_t)r32 * 512 + hi * 32 + 16) : "memory");
        ATT_DMA(0, 0); ATT_DMA(1, 1);
        if (IPS == 2) asm volatile("s_waitcnt vmcnt(2)\n\ts_barrier" : "+v"(qa), "+v"(qb_) :: "memory"); else asm volatile("s_waitcnt vmcnt(3)\n\ts_barrier" : "+v"(qa), "+v"(qb_) :: "memory");
        q8 = (v8i){(int)qa[0], (int)qa[1], (int)qa[2], (int)qa[3], (int)qb_[0], (int)qb_[1], (int)qb_[2], (int)qb_[3]};
    } else { const bf16* Qw = (const bf16*)Qp_ + (size_t)(qb * 256 + wid * 32) * 512;
#pragma unroll
        for (int d0 = 0; d0 < 4; ++d0) asm volatile("global_load_dwordx4 %0, %1, off" : "=v"(qr[d0]) : "v"(Qw + (size_t)r32 * 512 + d0 * 16 + hi * 8) : "memory");
        ATT_DMA(0, 0); ATT_DMA(1, 1);
        if (IPS == 2) asm volatile("s_waitcnt vmcnt(2)\n\ts_barrier" : "+v"(qr[0]), "+v"(qr[1]), "+v"(qr[2]), "+v"(qr[3]) :: "memory"); else asm volatile("s_waitcnt vmcnt(3)\n\ts_barrier" : "+v"(qr[0]), "+v"(qr[1]), "+v"(qr[2]), "+v"(qr[3]) :: "memory");
    }
    float mref = 0.f;
    f32x16 o[ND], osum = {}, negm = {}, SA0, SA1;
#pragma unroll
    for (int d = 0; d < ND; ++d) o[d] = f32x16{};
    v8i pa = {}; v4u pw[4] = {};
#define ATT_X(j) do { if (FQ) qkt8(SA0, SA1, shm + LDS_K + (j) * KSL, q8, negm, r32, hi); else qkt_c<false>(SA0, SA1, shm + LDS_K + (j) * KSL, qr, nullptr, negm, r32, hi); \
        soft_ref<ND>(SA0, SA1, negm, mref, o, osum, wsf, r32, hi, (j) == 0 && t == 0); \
        soft_exp<MASKED, FP>(SA0, SA1, MASKED ? *(const LAS u64*)(mring + (j) * 256 + r32 * 8) : 0ull, pa, pw, hi); } while (0)
#define ATT_Y(j) do { if (FP) pv8<ND>(o, osum, shm + LDS_V + (j) * VSL, (const LAS char*)(size_t)onesa, pa, r32, hi); else pv2<ND>(o, osum, vp0 + (j) * VSL, pw); } while (0)
#define ATT_STEP_A(j) do { const int tt = t + (j); if (tt + 2 < NT) ATT_DMA(tt + 2, ((j) + 2) & 3); \
        if (tt <= cq) { ATT_X(j); ATT_Y(j); } if (tt + 2 < NT) ATT_WAITN(IPS); else ATT_WAITN(0); } while (0)
    if (!STAG && wid >= 4) __builtin_amdgcn_s_setprio(1);
#define ATT_STEP_B(j) do { const int tt = t + (j); if (tt + 2 < NT) ATT_DMA(tt + 2, ((j) + 2) & 3); \
        if (tt > 0 && tt - 1 <= cq) ATT_Y(((j) + 3) & 3); if (tt <= cq) ATT_X(j); if (tt + 2 < NT) ATT_WAITN(IPS); else ATT_WAITN(0); } while (0)
    if (!STAG || wid < 4) { for (int t = 0; t < NT; t += 4) { ATT_STEP_A(0); ATT_STEP_A(1); ATT_STEP_A(2); ATT_STEP_A(3); } }
    else { for (int t = 0; t < NT; t += 4) { ATT_STEP_B(0); ATT_STEP_B(1); ATT_STEP_B(2); ATT_STEP_B(3); }
        if (NT - 1 <= cq) ATT_Y(3); }
    __builtin_amdgcn_s_setprio(0);
#undef ATT_STEP_B
#undef ATT_STEP_A
#undef ATT_WAITN
    asm volatile("s_waitcnt lgkmcnt(0)\n\ts_barrier" ::: "memory");
#undef ATT_X
#undef ATT_Y
#undef ATT_DMA
    float rli[16];
#pragma unroll
    for (int r = 0; r < 16; ++r) rli[r] = __builtin_amdgcn_rcpf(osum[r]);
    LAS bf16* stg = (LAS bf16*)(shm + LDS_OST) + wid * (32 * DV);
    const size_t orow0 = (size_t)(qb * 256 + wid * 32);
    if (OUT == 1) {
#pragma unroll
        for (int r = 0; r < 16; ++r)
#pragma unroll
            for (int d = 0; d < ND; ++d) O0s[(size_t)(wid * 32 + crow(r, hi)) * DV + d * 32 + r32] = o[d][r] * rli[r];
    } else {
        if (OUT == 2) {
            float gv[ND];
#pragma unroll
            for (int d = 0; d < ND; ++d) gv[d] = gsub[d * 32 + r32] * osc;
#pragma unroll
            for (int r = 0; r < 16; ++r) { float ss = 0.f;
#pragma unroll
                for (int d = 0; d < ND; ++d) { const float v = O0s[(size_t)(wid * 32 + crow(r, hi)) * DV + d * 32 + r32] - lam * (o[d][r] * rli[r]); o[d][r] = v; ss += v * v; }
#pragma unroll
                for (int x = 1; x < 32; x <<= 1) ss += __shfl_xor(ss, x);
                const float rs = __builtin_amdgcn_rsqf(ss * (1.0f / DV) + 1e-6f);
#pragma unroll
                for (int d = 0; d < ND; ++d) o[d][r] = o[d][r] * rs * gv[d]; }
#pragma unroll
            for (int r = 0; r < 16; ++r) rli[r] = 1.0f;
        }
#pragma unroll
        for (int r = 0; r < 16; ++r) { const int orow = crow(r, hi);
#pragma unroll
            for (int d = 0; d < ND; ++d) stg[orow * DV + d * 32 + r32] = (bf16)f2bf(o[d][r] * rli[r]); }
        LDS_WAIT();
        constexpr int CH = DV / 8, RPI = 64 / CH;
#pragma unroll
        for (int i = 0; i < 32 / RPI; ++i) { const int row = i * RPI + lane / CH, ch = lane % CH; const v4u v = *(const LAS v4u*)(stg + row * DV + ch * 8);
            *(v4u*)(Od + (orow0 + row) * 1024 + ch * 8) = v; }
    }
    asm volatile("s_waitcnt lgkmcnt(0)\n\ts_barrier" ::: "memory");
}
}

__device__ __forceinline__ void attention_phase(Frame& F0, const Inputs& I, int layer) {
    Frame F = F0; { int t_ = F0.tid; asm volatile("" : "+v"(t_)); F.tid = t_; F.lane = t_ & 63; F.wave = __builtin_amdgcn_readfirstlane(t_ >> 6); }
    const unsigned char* QKVb = F.ws + WS_QKV;
    bf16* MIX = (bf16*)(F.ws + WS_MIX); const GAS u64* MASK = (const GAS u64*)(F.ws + WS_MASK);
    LAS char* shm = (LAS char*)F.lds;
    static_assert(DIFF_Q1 && DIFF_FP, "the tile-major K / V^T layouts are written for this configuration (fp8 P.V, second component's QK^T on fp8)");
    const float lam_init = (layer == 0) ? 0.2f : 0.35550906759096926f;
    for (int v = F.vcu; v < 256; v += F.G) {
        { const int bh = v >> 3, b = bh >> 3, h = bh & 7, s = v & 7; const size_t ro = (size_t)b * T * 512 + h * 64;
#pragma unroll 1
          for (int i = 0; i < 4; ++i) { const int qb = (i == 0) ? s : (i == 1) ? 15 - s : (i == 2) ? 16 + s : 31 - s;
              { int t_ = F.tid; asm volatile("" : "+v"(t_)); F.lane = t_ & 63; F.wave = __builtin_amdgcn_readfirstlane(t_ >> 6); }
              att::attn_unit<64, true, 0, true, true, ATT_STAG_DSA>(shm, F.wave, F.lane, QKVb + pg8::QKV_Q8A + ro, QKVb + pg8::QKV_K8A + (size_t)(b * 8 + h) * 128 * 4096, QKVb + pg8::QKV_VT8A + (size_t)(b * 8 + h) * 128 * 4096, qb, MASK + (size_t)b * 128 * T, MIX + (size_t)b * T * 1024 + h * 64, nullptr, 0.f, 0.f, nullptr); } }
        { const int bh = v >> 4, b = bh >> 2, h = bh & 3, s = v & 15; float* O0s = (float*)(F.ws + WS_O0) + (size_t)blockIdx.x * (256 * 128);
          const float* gsub = I.g_subln + layer * 128;
          const float d1 = wave_sum(I.lq1[layer * 64 + F.lane] * I.lk1[layer * 64 + F.lane]), d2 = wave_sum(I.lq2[layer * 64 + F.lane] * I.lk2[layer * 64 + F.lane]);
          const float lam = __expf(d1) - __expf(d2) + lam_init;
#pragma unroll 1
          for (int i = 0; i < 2; ++i) { const int qb = (i == 0) ? s : 31 - s;
              const size_t r0 = (size_t)b * T * 512 + (2 * h) * 64, r1 = r0 + 64;
              const bf16* QB = (const bf16*)(QKVb + pg8::QKV_QB); const bf16* KB = (const bf16*)(QKVb + pg8::QKV_KB);
              const void* vsrc_ = DIFF_FP ? (const void*)(QKVb + pg8::QKV_VT8B + (size_t)(b * 4 + h) * 128 * 8192) : (const void*)((const bf16*)(QKVb + pg8::QKV_VB) + (size_t)b * T * 512 + h * 128);
              { int t_ = F.tid; asm volatile("" : "+v"(t_)); F.lane = t_ & 63; F.wave = __builtin_amdgcn_readfirstlane(t_ >> 6); }
              att::attn_unit<128, false, 1, false, DIFF_FP, ATT_STAG_DIFF>(shm, F.wave, F.lane, QB + r0, QKVb + pg8::QKV_KB + (size_t)(b * 4 + h) * 128 * 8192, vsrc_, qb, nullptr, nullptr, O0s, 0.f, 0.f, nullptr);
              { int t_ = F.tid; asm volatile("" : "+v"(t_)); F.lane = t_ & 63; F.wave = __builtin_amdgcn_readfirstlane(t_ >> 6); }
              if (DIFF_Q1 && DIFF_FP) att::attn_unit<128, false, 2, true, true, ATT_STAG_DIFF>(shm, F.wave, F.lane, F.ws + WS_Q8B + r1, F.ws + WS_K8B + (size_t)(b * 4 + h) * 128 * 4096, vsrc_, qb, nullptr, MIX + (size_t)b * T * 1024 + 512 + h * 128, O0s, lam, 1.0f - lam_init, gsub);
              else att::attn_unit<128, false, 2, false, DIFF_FP, ATT_STAG_DIFF>(shm, F.wave, F.lane, QB + r1, KB + r1, vsrc_, qb, nullptr, MIX + (size_t)b * T * 1024 + 512 + h * 128, O0s, lam, 1.0f - lam_init, gsub); } }
    }
}

struct Args { const float* in[14]; float* out; unsigned char* ws; };
__global__ void __launch_bounds__(NWAVES * 64, 2) fwd_kernel(Args args) {
    extern __shared__ __attribute__((aligned(16))) unsigned char lds[];
    Frame F;
    F.lds = (LAS unsigned char*)lds;
    F.MISC = (volatile LAS unsigned*)(F.lds + MISC_OFF);
    F.tid = threadIdx.x; F.lane = F.tid & 63; F.wave = __builtin_amdgcn_readfirstlane(F.tid >> 6);
    F.G = gridDim.x; { const int bx = blockIdx.x; F.vcu = (F.G % 8 == 0) ? (bx % 8) * (F.G / 8) + bx / 8 : bx; }
    F.ws = args.ws; F.ctl = (gu32*)(args.ws + WS_CTL);
    Inputs I; I.x = args.in[0]; I.w_in = args.in[1]; I.w_out = args.in[2]; I.g_mix = args.in[3]; I.lq1 = args.in[4]; I.lk1 = args.in[5]; I.lq2 = args.in[6]; I.lk2 = args.in[7];
    I.g_subln = args.in[8]; I.g_ffn = args.in[9]; I.w_gate = args.in[10]; I.w_up = args.in[11]; I.w_down = args.in[12]; I.g_final = args.in[13];
    for (int u = F.tid; u < (LDS_BYTES - LDSCTL_OFF) / 4; u += NWAVES * 64) ((LAS unsigned*)(F.lds + LDSCTL_OFF))[u] = 0u;
    __syncthreads();
    XcdBarrier bar = xcd_barrier_post((unsigned*)(F.ctl + CW_BAR), F.MISC + 8);
    u64* ssq = (u64*)(args.ws + WS_SSQ); bf16* XN = (bf16*)(args.ws + WS_XN); float* out = args.out;
#define GRID_BAR() do { XcdBarrier b_ = bar; asm volatile("" : "+s"(b_.x)); xcd_barrier(b_); } while (0)

    p0_prologue(F, I);
    GRID_BAR();
#pragma unroll 1
    for (int l = 0; l < NLAYER; ++l) {
        unsigned char* wl = args.ws + WS_W + (size_t)l * W_LAYER;
        {
            pg8::Gemm g{XN, (const bf16*)(wl + WO_IN), M, DINP, D}; pg8::StaticOrder S; S.init(M, DINP, F.G, (int)blockIdx.x);
            pg8::EpiIn E{ssq + (size_t)(2 * l) * M, (unsigned char*)(args.ws + WS_QKV), (bf16*)(args.ws + WS_IQ), (bf16*)(args.ws + WS_IK), (float*)(args.ws + WS_IW), (const float*)(args.ws + WS_CS64), (const float*)(args.ws + WS_CS32), args.ws + WS_Q8B, args.ws + WS_K8B};
            pg8::gemm_phase<pg8::EpiIn, pg8::StaticOrder, true, true>(F.lds, g, S, E);
        }
        GRID_BAR();
        select_phase(F, out);
        GRID_BAR();
        attention_phase(F, I, l);
        GRID_BAR();
        {
            pg8::Gemm g{(const bf16*)(args.ws + WS_MIX), (const bf16*)(wl + WO_OUT), M, D, D}; pg8::StaticOrder S; S.init(M, D, F.G, (int)blockIdx.x);
            pg8::EpiRes E{XN, ssq + (size_t)(2 * l + 1) * M};
            pg8::gemm_phase<pg8::EpiRes, pg8::StaticOrder, false, true>(F.lds, g, S, E);
        }
        GRID_BAR();
        {
            pg8::Gemm g{XN, (const bf16*)(wl + WO_GU), M, NGU, D}; pg8::StaticOrder S; S.init(M, NGU, F.G, (int)blockIdx.x);
            pg8::EpiGU E{ssq + (size_t)(2 * l + 1) * M, (bf16*)(args.ws + WS_H)};
            pg8::gemm_phase<pg8::EpiGU, pg8::StaticOrder, true, true>(F.lds, g, S, E);
        }
        GRID_BAR();
        {
            pg8::Gemm g{(const bf16*)(args.ws + WS_H), (const bf16*)(wl + WO_DN), M, D, DFF}; pg8::StaticOrder S; S.init(M, D, F.G, (int)blockIdx.x);
            pg8::EpiRes E{XN, ssq + (size_t)(2 * l + 2) * M};
            pg8::gemm_phase<pg8::EpiRes, pg8::StaticOrder, false, true>(F.lds, g, S, E);
        }
        GRID_BAR();
    }
    final_norm(F, out, XN, ssq + (size_t)4 * M, I.g_final);
}

extern "C" void kernel_launch(void* const* d_in, const int* in_sizes, int n_in, void* d_out, int out_size, void* d_ws, size_t ws_size, hipStream_t stream) {
    static int grid = 0;
    if (grid == 0) {
        if (n_in != 14 || in_sizes[0] != M * D || out_size != M * D || ws_size < WS_END) { fprintf(stderr, "kernel_launch: shape/workspace mismatch (n_in %d, in0 %d, out %d, ws %zu); nothing launched\n", n_in, n_in > 0 ? in_sizes[0] : -1, out_size, ws_size); grid = -1; return; }
        int dev = 0, cus = 0, per_cu = 0;
        if (hipGetDevice(&dev) != hipSuccess || hipDeviceGetAttribute(&cus, hipDeviceAttributeMultiprocessorCount, dev) != hipSuccess) { grid = -1; return; }
        if (hipFuncSetAttribute((const void*)fwd_kernel, hipFuncAttributeMaxDynamicSharedMemorySize, LDS_BYTES) != hipSuccess) { fprintf(stderr, "kernel_launch: hipFuncSetAttribute failed\n"); grid = -1; return; }
        if (hipOccupancyMaxActiveBlocksPerMultiprocessor(&per_cu, (const void*)fwd_kernel, NWAVES * 64, LDS_BYTES) != hipSuccess || per_cu < 1) fprintf(stderr, "kernel_launch: occupancy query reports %d\n", per_cu);
        (void)hipGetLastError();
        grid = cus;
    }
    if (grid < 0) return;
    if (hipMemsetAsync((char*)d_ws + WS_CTL, 0, CTL_ZERO_BYTES, stream) != hipSuccess) return;
    Args a{};
    for (int i = 0; i < 14; ++i) a.in[i] = (const float*)d_in[i];
    a.out = (float*)d_out; a.ws = (unsigned char*)d_ws;
    hipLaunchKernelGGL(fwd_kernel, dim3(grid), dim3(NWAVES * 64), LDS_BYTES, stream, a);
}
```
